# Optimizing an MI355X kernel written in HIP

```python
import math
import jax
import jax.numpy as jnp
from jax import lax
import numpy as np

D_MODEL = 2048
BATCH = 1
SEQ = 8192
DEPTH = 2

N_EVEN = (DEPTH + 1) // 2
N_ODD = DEPTH // 2
Q_BLOCK = 128
EPS = 1e-6
NEG_INF = -1e30

NSA_HEADS = 8
NSA_KV_HEADS = 2
NSA_GROUP = NSA_HEADS // NSA_KV_HEADS
NSA_HEAD_DIM = 128
CMP_LEN = 32
CMP_STRIDE = 16
CMP_HIDDEN = 256
SLC_LEN = 64
SLC_TOPN = 16
WINDOW = 512

MLA_HEADS = 8
MLA_Q_RANK = 512
MLA_KV_RANK = 512
MLA_NOPE = 128
MLA_ROPE = 64
MLA_V = 128
ROPE_THETA = 10000.0

FOX_HEADS = 16
FOX_HEAD_DIM = D_MODEL // FOX_HEADS

REL_BUCKETS = 32
REL_MAX_DIST = 4096

FFN_HIDDEN = ((8 * D_MODEL + 2) // 3 + 255) // 256 * 256

EVEN_SPLITS = (NSA_HEADS * NSA_HEAD_DIM, 3 * 2 * NSA_KV_HEADS * NSA_HEAD_DIM, 3 * NSA_HEADS,
               MLA_Q_RANK, MLA_KV_RANK, MLA_ROPE)
EVEN_IN = sum(EVEN_SPLITS)
EVEN_MIX = NSA_HEADS * NSA_HEAD_DIM + MLA_HEADS * MLA_V
FOX_SPLITS = (D_MODEL, D_MODEL, D_MODEL, FOX_HEADS, D_MODEL)
FOX_IN = sum(FOX_SPLITS)

kernel_name = 'hybrid_nsa_mla_fox_trunk'


def _split(a, sizes):
    return jnp.split(a, np.cumsum(sizes)[:-1].tolist(), axis=-1)


def rmsnorm(x, g):
    xf = x.astype(jnp.float32)
    y = xf * lax.rsqrt(jnp.mean(xf * xf, axis=-1, keepdims=True) + EPS)
    return (y * g.astype(jnp.float32)).astype(x.dtype)


def masked_softmax(logits, mask):
    l = jnp.where(mask, logits.astype(jnp.float32), NEG_INF)
    m = jnp.max(l, axis=-1, keepdims=True)
    p = jnp.where(mask, jnp.exp(l - m), 0.0)
    return p / jnp.maximum(jnp.sum(p, axis=-1, keepdims=True), 1e-30)


def t5_bucket(dist):
    max_exact = REL_BUCKETS // 2
    d = jnp.maximum(dist, 0)
    ratio = jnp.log(jnp.maximum(d, max_exact).astype(jnp.float32) / max_exact) / math.log(REL_MAX_DIST / max_exact)
    large = jnp.minimum(max_exact + (ratio * (REL_BUCKETS - max_exact)).astype(jnp.int32), REL_BUCKETS - 1)
    return jnp.where(d < max_exact, d, large)


def rope(x, positions):
    half = x.shape[-1] // 2
    inv = ROPE_THETA ** (-jnp.arange(half, dtype=jnp.float32) / half)
    ang = positions.astype(jnp.float32)[..., None] * inv
    ang = ang.reshape(ang.shape[:2] + (1,) * (x.ndim - 3) + (half,))
    cos, sin = jnp.cos(ang), jnp.sin(ang)
    x1, x2 = x[..., :half], x[..., half:]
    return jnp.concatenate([x1 * cos - x2 * sin, x1 * sin + x2 * cos], axis=-1).astype(x.dtype)


def swiglu(h, w1, w3, w2):
    return (jax.nn.silu(h @ w1) * (h @ w3)) @ w2


def sweep_query_blocks(fn, batch, seq):
    out = lax.map(fn, jnp.arange(seq // Q_BLOCK))
    return jnp.moveaxis(out, 0, 1).reshape(batch, seq, out.shape[-1])


def selection_map(n_cmp, n_slc):
    start = np.arange(n_cmp)[:, None] * CMP_STRIDE
    j0 = np.arange(n_slc)[None, :] * SLC_LEN
    return jnp.asarray(((start < j0 + SLC_LEN) & (start + CMP_LEN > j0)).astype(np.float32))


def nsa_compress(k, pos_emb, w1, w2):
    B, S, G, d = k.shape
    n_cmp = (S - CMP_LEN) // CMP_STRIDE + 1
    idx = np.arange(n_cmp)[:, None] * CMP_STRIDE + np.arange(CMP_LEN)[None, :]
    blk = k[:, idx] + pos_emb[:, None, :]
    blk = blk.transpose(0, 1, 3, 2, 4).reshape(B, n_cmp, G, CMP_LEN * d)
    return jax.nn.silu(blk @ w1) @ w2


def nsa_attend(q, kc, vc, ks, vs, kw, vw, gates, positions, rel_bias):
    B, S = q.shape[0], q.shape[1]
    G, R, d = NSA_KV_HEADS, NSA_GROUP, NSA_HEAD_DIM
    n_cmp, n_slc = kc.shape[1], S // SLC_LEN
    top_n = min(SLC_TOPN, n_slc)
    kwin = WINDOW + Q_BLOCK
    n_sel_tok = top_n * SLC_LEN
    scale = NSA_HEAD_DIM ** -0.5
    tbl = rel_bias.T
    tbl_g = tbl.reshape(G, R, REL_BUCKETS)
    cmp_end = jnp.arange(n_cmp) * CMP_STRIDE + (CMP_LEN - 1)
    cmp_pos = positions[:, cmp_end]
    sel_map = selection_map(n_cmp, n_slc)
    ks_blk = ks.reshape(B, n_slc, SLC_LEN, G, d).transpose(0, 3, 1, 2, 4)
    vs_blk = vs.reshape(B, n_slc, SLC_LEN, G, d).transpose(0, 3, 1, 2, 4)
    pad = ((0, 0), (WINDOW, 0), (0, 0), (0, 0))
    kw_pad, vw_pad = jnp.pad(kw, pad), jnp.pad(vw, pad)
    pos_pad = jnp.pad(positions, ((0, 0), (WINDOW, 0)))
    bi = jnp.arange(B)[:, None, None, None]
    gi = jnp.arange(G)[None, :, None, None]
    ri = jnp.arange(R)[None, None, :, None, None]
    blk_ids = jnp.arange(n_slc)

    def block(qb):
        qs = qb * Q_BLOCK
        t = qs + jnp.arange(Q_BLOCK)
        qq = lax.dynamic_slice_in_dim(q, qs, Q_BLOCK, 1)
        pq = lax.dynamic_slice_in_dim(positions, qs, Q_BLOCK, 1)

        bias_c = tbl[:, t5_bucket(pq[:, :, None] - cmp_pos[:, None, :])]
        bias_c = bias_c.transpose(1, 0, 2, 3).reshape(B, G, R, Q_BLOCK, n_cmp)
        logit_c = jnp.einsum('bqgrd,bngd->bgrqn', qq, kc).astype(jnp.float32) * scale + bias_c
        p_c = masked_softmax(logit_c, cmp_end[None, :] <= t[:, None])
        o_c = jnp.einsum('bgrqn,bngd->bqgrd', p_c.astype(vc.dtype), vc)

        imp = jnp.einsum('bgrqn,nj->bgqj', p_c, sel_map)
        cur = (t // SLC_LEN)[:, None]
        forced = (blk_ids == 0) | (blk_ids == cur) | (blk_ids == cur - 1)
        imp = jnp.where(forced, 1e9, jnp.where(blk_ids <= cur, imp, -1e9))
        _, sel = lax.top_k(imp, top_n)
        k_sel = ks_blk[bi, gi, sel].reshape(B, G, Q_BLOCK, n_sel_tok, d)
        v_sel = vs_blk[bi, gi, sel].reshape(B, G, Q_BLOCK, n_sel_tok, d)
        tok = (sel[..., None] * SLC_LEN + jnp.arange(SLC_LEN)).reshape(B, G, Q_BLOCK, n_sel_tok)
        bucket_s = t5_bucket(pq[:, None, :, None] - positions[bi, tok])
        bias_s = tbl_g[gi[..., None], ri, bucket_s[:, :, None]]
        logit_s = jnp.einsum('bqgrd,bgqkd->bgrqk', qq, k_sel).astype(jnp.float32) * scale + bias_s
        p_s = masked_softmax(logit_s, (tok <= t[:, None])[:, :, None])
        o_s = jnp.einsum('bgrqk,bgqkd->bqgrd', p_s.astype(v_sel.dtype), v_sel)

        kk = lax.dynamic_slice_in_dim(kw_pad, qs, kwin, 1)
        vv = lax.dynamic_slice_in_dim(vw_pad, qs, kwin, 1)
        pk = lax.dynamic_slice_in_dim(pos_pad, qs, kwin, 1)
        s_idx = qs - WINDOW + jnp.arange(kwin)
        rel = t[:, None] - s_idx[None, :]
        mask_w = (s_idx[None, :] >= 0) & (rel >= 0) & (rel < WINDOW)
        bias_w = tbl[:, t5_bucket(pq[:, :, None] - pk[:, None, :])]
        bias_w = bias_w.transpose(1, 0, 2, 3).reshape(B, G, R, Q_BLOCK, kwin)
        logit_w = jnp.einsum('bqgrd,bkgd->bgrqk', qq, kk).astype(jnp.float32) * scale + bias_w
        p_w = masked_softmax(logit_w, mask_w)
        o_w = jnp.einsum('bgrqk,bkgd->bqgrd', p_w.astype(vv.dtype), vv)

        g = lax.dynamic_slice_in_dim(gates, qs, Q_BLOCK, 1).reshape(B, Q_BLOCK, G, R, 3)
        o = g[..., 0:1] * o_c + g[..., 1:2] * o_s + g[..., 2:3] * o_w
        return o.reshape(B, Q_BLOCK, G * R * d)

    return sweep_query_blocks(block, B, S)


def mla_attend(q_nope, q_rope, k_nope, k_rope, v):
    B, S, H, dv = v.shape
    scale = (MLA_NOPE + MLA_ROPE) ** -0.5
    kpos = jnp.arange(S)

    def block(qb):
        qs = qb * Q_BLOCK
        t = qs + jnp.arange(Q_BLOCK)
        qn = lax.dynamic_slice_in_dim(q_nope, qs, Q_BLOCK, 1)
        qr = lax.dynamic_slice_in_dim(q_rope, qs, Q_BLOCK, 1)
        logit = (jnp.einsum('bqhd,bkhd->bhqk', qn, k_nope)
                 + jnp.einsum('bqhd,bkd->bhqk', qr, k_rope)).astype(jnp.float32) * scale
        p = masked_softmax(logit, kpos[None, :] <= t[:, None])
        return jnp.einsum('bhqk,bkhd->bqhd', p.astype(v.dtype), v).reshape(B, Q_BLOCK, H * dv)

    return sweep_query_blocks(block, B, S)


def nsa_mla_mixer(h, positions, rel_bias, w_in, w_out, gate_b,
                  pos_k, w1_k, w2_k, pos_v, w1_v, w2_v,
                  q_norm, w_uq, kv_norm, w_ukv):
    B, S, _ = h.shape
    G, R, d = NSA_KV_HEADS, NSA_GROUP, NSA_HEAD_DIM
    q_nsa, kv_nsa, g_nsa, cq, ckv, kr = _split(h @ w_in, EVEN_SPLITS)
    q_nsa = q_nsa.reshape(B, S, G, R, d)
    kv = kv_nsa.reshape(B, S, 3, 2, G, d)
    gates = jax.nn.sigmoid(g_nsa + gate_b).reshape(B, S, NSA_HEADS, 3)
    kc = nsa_compress(kv[:, :, 0, 0], pos_k, w1_k, w2_k)
    vc = nsa_compress(kv[:, :, 0, 1], pos_v, w1_v, w2_v)
    o_nsa = nsa_attend(q_nsa, kc, vc, kv[:, :, 1, 0], kv[:, :, 1, 1], kv[:, :, 2, 0], kv[:, :, 2, 1],
                       gates, positions, rel_bias)
    qh = (rmsnorm(cq, q_norm) @ w_uq).reshape(B, S, MLA_HEADS, MLA_NOPE + MLA_ROPE)
    q_nope, q_rope = qh[..., :MLA_NOPE], rope(qh[..., MLA_NOPE:], positions)
    kvh = (rmsnorm(ckv, kv_norm) @ w_ukv).reshape(B, S, MLA_HEADS, MLA_NOPE + MLA_V)
    k_nope, v = kvh[..., :MLA_NOPE], kvh[..., MLA_NOPE:]
    o_mla = mla_attend(q_nope, q_rope, k_nope, rope(kr, positions), v)
    return jnp.concatenate([o_nsa, o_mla], axis=-1) @ w_out


def fox_mixer(h, w_in, w_out, f_b, q_norm, k_norm):
    B, S, _ = h.shape
    H, dh = FOX_HEADS, FOX_HEAD_DIM
    q, k, v, f, og = _split(h @ w_in, FOX_SPLITS)
    q = rmsnorm(q.reshape(B, S, H, dh), q_norm)
    k = rmsnorm(k.reshape(B, S, H, dh), k_norm)
    v = v.reshape(B, S, H, dh)
    cum = lax.cumsum(jax.nn.log_sigmoid((f + f_b).astype(jnp.float32)), axis=1).transpose(0, 2, 1)
    scale = dh ** -0.5
    kpos = jnp.arange(S)

    def block(qb):
        qs = qb * Q_BLOCK
        t = qs + jnp.arange(Q_BLOCK)
        qq = lax.dynamic_slice_in_dim(q, qs, Q_BLOCK, 1)
        cq = lax.dynamic_slice_in_dim(cum, qs, Q_BLOCK, 2)
        logit = (jnp.einsum('bqhd,bkhd->bhqk', qq, k).astype(jnp.float32) * scale
                 + cq[..., None] - cum[:, :, None, :])
        p = masked_softmax(logit, kpos[None, :] <= t[:, None])
        return jnp.einsum('bhqk,bkhd->bqhd', p.astype(v.dtype), v).reshape(B, Q_BLOCK, H * dh)

    o = sweep_query_blocks(block, B, S)
    return (o * jax.nn.sigmoid(og)) @ w_out


def setup_inputs(seed: int = 0) -> dict:
    key = jax.random.key(seed)
    ks = jax.random.split(key, 32)
    f32 = jnp.float32
    D, F = D_MODEL, FFN_HIDDEN

    def nrm(k, shape, fan_in, scale=1.0):
        return jax.random.normal(k, shape, f32) * (scale * fan_in ** -0.5)

    def gain(k, shape):
        return 1.0 + 0.05 * jax.random.normal(k, shape, f32)

    return {
        'x': jax.random.normal(ks[0], (BATCH, SEQ, D), f32),
        'c': jax.random.normal(ks[1], (BATCH, D), f32),
        'positions': jnp.tile(jnp.arange(SEQ, dtype=jnp.int32)[None, :], (BATCH, 1)),
        'rel_bias': 0.5 * jax.random.normal(ks[2], (REL_BUCKETS, NSA_HEADS), f32),
        'ada_w': nrm(ks[3], (DEPTH, D, 6 * D), D, 0.5),
        'ada_b': 0.02 * jax.random.normal(ks[4], (DEPTH, 6 * D), f32),
        'norm_mix': gain(ks[5], (DEPTH, D)),
        'norm_ffn': gain(ks[6], (DEPTH, D)),
        'ffn_w1': nrm(ks[7], (DEPTH, D, F), D),
        'ffn_w3': nrm(ks[8], (DEPTH, D, F), D),
        'ffn_w2': nrm(ks[9], (DEPTH, F, D), F),
        'even_w_in': nrm(ks[10], (N_EVEN, D, EVEN_IN), D),
        'even_w_out': nrm(ks[11], (N_EVEN, EVEN_MIX, D), EVEN_MIX),
        'nsa_gate_b': 0.1 * jax.random.normal(ks[12], (N_EVEN, 3 * NSA_HEADS), f32),
        'nsa_cmp_pos_k': 0.1 * jax.random.normal(ks[13], (N_EVEN, CMP_LEN, NSA_HEAD_DIM), f32),
        'nsa_cmp_w1_k': nrm(ks[14], (N_EVEN, CMP_LEN * NSA_HEAD_DIM, CMP_HIDDEN), CMP_LEN * NSA_HEAD_DIM),
        'nsa_cmp_w2_k': nrm(ks[15], (N_EVEN, CMP_HIDDEN, NSA_HEAD_DIM), CMP_HIDDEN),
        'nsa_cmp_pos_v': 0.1 * jax.random.normal(ks[16], (N_EVEN, CMP_LEN, NSA_HEAD_DIM), f32),
        'nsa_cmp_w1_v': nrm(ks[17], (N_EVEN, CMP_LEN * NSA_HEAD_DIM, CMP_HIDDEN), CMP_LEN * NSA_HEAD_DIM),
        'nsa_cmp_w2_v': nrm(ks[18], (N_EVEN, CMP_HIDDEN, NSA_HEAD_DIM), CMP_HIDDEN),
        'mla_q_norm': gain(ks[19], (N_EVEN, MLA_Q_RANK)),
        'mla_w_uq': nrm(ks[20], (N_EVEN, MLA_Q_RANK, MLA_HEADS * (MLA_NOPE + MLA_ROPE)), MLA_Q_RANK),
        'mla_kv_norm': gain(ks[21], (N_EVEN, MLA_KV_RANK)),
        'mla_w_ukv': nrm(ks[22], (N_EVEN, MLA_KV_RANK, MLA_HEADS * (MLA_NOPE + MLA_V)), MLA_KV_RANK),
        'fox_w_in': nrm(ks[23], (N_ODD, D, FOX_IN), D),
        'fox_w_out': nrm(ks[24], (N_ODD, D, D), D),
        'fox_f_b': 2.0 + 4.0 * jax.random.uniform(ks[25], (N_ODD, FOX_HEADS), f32),
        'fox_q_norm': gain(ks[26], (N_ODD, FOX_HEAD_DIM)),
        'fox_k_norm': gain(ks[27], (N_ODD, FOX_HEAD_DIM)),
        'final_norm': gain(ks[28], (D,)),
    }


def reference(x, c, positions, rel_bias, ada_w, ada_b, norm_mix, norm_ffn,
              ffn_w1, ffn_w3, ffn_w2, even_w_in, even_w_out, nsa_gate_b,
              nsa_cmp_pos_k, nsa_cmp_w1_k, nsa_cmp_w2_k, nsa_cmp_pos_v, nsa_cmp_w1_v, nsa_cmp_w2_v,
              mla_q_norm, mla_w_uq, mla_kv_norm, mla_w_ukv,
              fox_w_in, fox_w_out, fox_f_b, fox_q_norm, fox_k_norm, final_norm):
    cond = jax.nn.silu(c)
    for i in range(DEPTH):
        mod = (cond @ ada_w[i] + ada_b[i])[:, None, :]
        sh1, sc1, g1, sh2, sc2, g2 = jnp.split(mod, 6, axis=-1)
        h = rmsnorm(x, norm_mix[i]) * (1.0 + sc1) + sh1
        if i % 2 == 0:
            e = i // 2
            y = nsa_mla_mixer(h, positions, rel_bias, even_w_in[e], even_w_out[e], nsa_gate_b[e],
                              nsa_cmp_pos_k[e], nsa_cmp_w1_k[e], nsa_cmp_w2_k[e],
                              nsa_cmp_pos_v[e], nsa_cmp_w1_v[e], nsa_cmp_w2_v[e],
                              mla_q_norm[e], mla_w_uq[e], mla_kv_norm[e], mla_w_ukv[e])
        else:
            o = i // 2
            y = fox_mixer(h, fox_w_in[o], fox_w_out[o], fox_f_b[o], fox_q_norm[o], fox_k_norm[o])
        x = x + g1 * y
        h = rmsnorm(x, norm_ffn[i]) * (1.0 + sc2) + sh2
        x = x + g2 * swiglu(h, ffn_w1[i], ffn_w3[i], ffn_w2[i])
    return rmsnorm(x, final_norm)
```

```cpp
#include <hip/hip_runtime.h>
#include <hip/hip_cooperative_groups.h>
#include <cstdio>
#include <cmath>
namespace cg = cooperative_groups;

typedef unsigned short u16;
typedef unsigned int u32;
using bf16x8 = __attribute__((ext_vector_type(8))) short;
using s16x4 = __attribute__((ext_vector_type(4))) short;
using f32x16 = __attribute__((ext_vector_type(16))) float;
using u32x4 = __attribute__((ext_vector_type(4))) unsigned int;
using f32x4 = __attribute__((ext_vector_type(4))) float;
using u32x2 = __attribute__((ext_vector_type(2))) unsigned int;
#define DI __device__ __forceinline__
#define SB0 __builtin_amdgcn_sched_barrier(0)
#define MFMA32(a, b, c) __builtin_amdgcn_mfma_f32_32x32x16_bf16((a), (b), (c), 0, 0, 0)

#ifndef MULTI
#define MULTI 0
#endif

constexpr int S_ = 8192, D_ = 2048, F_ = 5632;
constexpr int NIN0 = 3712;
constexpr int NIN1 = 8320;
constexpr float LOG2E = 1.4426950408889634f;
constexpr float NEGB = -1e30f;

constexpr size_t AL(size_t x) { return (x + 255) & ~(size_t)255; }
constexpr size_t O_WIN = 0;
constexpr size_t O_WOUT = O_WIN + AL((size_t)NIN0 * 2048 * 2);
constexpr size_t O_W1K = O_WOUT + AL((size_t)2048 * 2048 * 2);
constexpr size_t O_W1V = O_W1K + AL((size_t)256 * 4096 * 2);
constexpr size_t O_W2K = O_W1V + AL((size_t)256 * 4096 * 2);
constexpr size_t O_W2V = O_W2K + AL((size_t)128 * 256 * 2);
constexpr size_t O_WUQ = O_W2V + AL((size_t)128 * 256 * 2);
constexpr size_t O_WUKV = O_WUQ + AL((size_t)1536 * 512 * 2);
constexpr size_t O_WFIN = O_WUKV + AL((size_t)2048 * 512 * 2);
constexpr size_t O_WFOUT = O_WFIN + AL((size_t)NIN1 * 2048 * 2);
constexpr size_t O_W13_0 = O_WFOUT + AL((size_t)2048 * 2048 * 2);
constexpr size_t O_W13_1 = O_W13_0 + AL((size_t)2 * F_ * 2048 * 2);
constexpr size_t O_W2_0 = O_W13_1 + AL((size_t)2 * F_ * 2048 * 2);
constexpr size_t O_W2_1 = O_W2_0 + AL((size_t)2048 * F_ * 2);
constexpr size_t O_MODP = O_W2_1 + AL((size_t)2048 * F_ * 2);
constexpr size_t O_MOD = O_MODP + AL((size_t)16 * 24576 * 4);
constexpr size_t O_C1P = O_MOD + AL((size_t)24576 * 4);
constexpr size_t O_C1 = O_C1P + AL((size_t)2 * 64 * 256 * 4);
constexpr size_t O_ROPE = O_C1 + AL((size_t)2 * 256 * 4);
constexpr size_t O_H = O_ROPE + AL((size_t)S_ * 32 * 8);
constexpr size_t O_X1 = O_H + AL((size_t)S_ * D_ * 2);
constexpr size_t O_U = O_X1 + AL((size_t)S_ * D_ * 4);
constexpr size_t O_MIX = O_U + AL((size_t)S_ * F_ * 2);
constexpr size_t O_L = O_MIX + AL((size_t)S_ * D_ * 2);
constexpr size_t O_QN = O_L;
constexpr size_t O_KCS = O_QN + AL((size_t)8 * S_ * 128 * 2);
constexpr size_t O_VCS = O_KCS + AL((size_t)2 * S_ * 128 * 2 + 8192);
constexpr size_t O_KS = O_VCS + AL((size_t)2 * S_ * 128 * 2 + 8192);
constexpr size_t O_VST = O_KS + AL((size_t)2 * S_ * 128 * 2);
constexpr size_t O_KW = O_VST + AL((size_t)2 * S_ * 128 * 2);
constexpr size_t O_VWT = O_KW + AL((size_t)2 * S_ * 128 * 2);
constexpr size_t O_CQ = O_VWT + AL((size_t)2 * S_ * 128 * 2);
constexpr size_t O_CKV = O_CQ + AL((size_t)S_ * 512 * 2);
constexpr size_t O_GATES = O_CKV + AL((size_t)S_ * 512 * 2);
constexpr size_t O_QM = O_GATES + AL((size_t)S_ * 24 * 4);
constexpr size_t O_KM = O_QM + AL((size_t)8 * S_ * 192 * 2);
constexpr size_t O_VMT = O_KM + AL((size_t)8 * S_ * 192 * 2);
constexpr size_t O_HC = O_VMT + AL((size_t)8 * S_ * 128 * 2);
constexpr size_t O_KC = O_HC + AL((size_t)4 * 512 * 256 * 2);
constexpr size_t O_VCT = O_KC + AL((size_t)2 * 512 * 128 * 2);
constexpr size_t O_OC = O_VCT + AL((size_t)2 * 512 * 128 * 2);
constexpr size_t O_OW = O_OC + AL((size_t)S_ * 1024 * 4);
constexpr size_t O_IMP = O_OW + AL((size_t)S_ * 1024 * 4);
constexpr size_t O_SELM = O_IMP + AL((size_t)8 * S_ * 128 * 4);
constexpr size_t O_KRAW = O_SELM + AL((size_t)2 * S_ * 16);
constexpr size_t O_HCP = O_KRAW + AL((size_t)S_ * 88 * 4);
constexpr size_t O_L0END = O_HCP + AL((size_t)4 * 4 * 512 * 256 * 4);
constexpr size_t O_QF = O_L;
constexpr size_t O_KF = O_QF + AL((size_t)16 * S_ * 128 * 2);
constexpr size_t O_VFT = O_KF + AL((size_t)16 * S_ * 128 * 2);
constexpr size_t O_OG = O_VFT + AL((size_t)16 * S_ * 128 * 2);
constexpr size_t O_FL = O_OG + AL((size_t)S_ * D_ * 2);
constexpr size_t O_CUM = O_FL + AL((size_t)4 * S_ * 16 * 4);
constexpr size_t O_L1END = O_CUM + AL((size_t)S_ * 16 * 4);
constexpr size_t O_BAR = (O_L0END > O_L1END ? O_L0END : O_L1END);
constexpr size_t WS_NEED = O_BAR + 16384;

struct ConvJob { const float* src; const float* src2; const float* scale; u16* dst; int ld; int K; int Nd; int map; };
constexpr int NJOBS = 14;
struct Params {
  const float *x, *c; const int* pos;
  const float *rel_bias, *ada_w, *ada_b, *norm_mix, *norm_ffn, *ffn_w1, *ffn_w3, *ffn_w2, *even_w_in, *even_w_out, *gate_b,
      *cmp_pos_k, *cmp_w1_k, *cmp_w2_k, *cmp_pos_v, *cmp_w1_v, *cmp_w2_v, *mla_q_norm, *mla_w_uq, *mla_kv_norm, *mla_w_ukv,
      *fox_w_in, *fox_w_out, *fox_f_b, *fox_q_norm, *fox_k_norm, *final_norm;
  float* out;
  char* ws;
  ConvJob jobs[NJOBS];
  float inv_freq[32];
  int t5thr[32];
};

constexpr int SMEM_BYTES = 63488;

DI u16 f2bf(float f) { __bf16 b = (__bf16)f; return __builtin_bit_cast(u16, b); }
DI float bf2f(u16 v) { return __uint_as_float(((u32)v) << 16); }
DI u32 pack2(float a, float b) { return (u32)f2bf(a) | ((u32)f2bf(b) << 16); }
DI int opq(int v) { asm volatile("" : "+v"(v)); return v; }
#define GAS __attribute__((address_space(1)))
template <class T> DI T* GP(T* q) { return (T*)(GAS T*)q; }
DI char* WS(const Params& p) { GAS char* w = (GAS char*)p.ws; asm volatile("" : "+s"(w)); return (char*)w; }
DI int otid() { int v = (int)threadIdx.x; asm volatile("" : "+v"(v)); return v; }
DI int crow0(int i) { return (i & 3) + 8 * (i >> 2); }
DI int crow(int i, int h) { return (i & 3) + 8 * (i >> 2) + 4 * h; }
DI float siluf(float v) { return v / (1.f + __expf(-v)); }
DI float sigmoidf(float v) { return 1.f / (1.f + __expf(-v)); }
DI float fexp2(float v) { return __builtin_amdgcn_exp2f(v); }
DI float shx32(float v) { return __shfl_xor(v, 32, 64); }
DI int t5_bucket(int d) {
  d = d < 0 ? 0 : d;
  const int dd = d > 4096 ? 4096 : d;
  const int e = 31 - __clz(dd | 1);
  int big = 8 + 2 * e + ((dd * dd) >> (2 * e + 1));
  big = big > 31 ? 31 : big;
  return d < 16 ? d : big;
}
DI bf16x8 pack8(const f32x16& x, int s) {
  u32 a = pack2(x[8 * s], x[8 * s + 1]), b = pack2(x[8 * s + 2], x[8 * s + 3]), c = pack2(x[8 * s + 4], x[8 * s + 5]), d = pack2(x[8 * s + 6], x[8 * s + 7]);
  uint4 v = make_uint4(a, b, c, d);
  return __builtin_bit_cast(bf16x8, v);
}

__device__ __constant__ int c_job_tiles[NJOBS] = {16 * 29, 16 * 16, 32 * 2, 32 * 2, 2 * 1, 2 * 1, 4 * 12, 4 * 16, 16 * 65, 16 * 16, 16 * 88, 16 * 88, 44 * 16, 44 * 16};
constexpr int CONV_TILES = 16 * 29 + 16 * 16 + 32 * 2 * 2 + 2 * 2 + 4 * 12 + 4 * 16 + 16 * 65 + 16 * 16 + 2 * 16 * 88 + 2 * 44 * 16;

static ConvJob get_job(const Params& p, int j) {
  ConvJob J; J.src2 = nullptr; J.scale = nullptr; J.map = 0;
  char* ws = p.ws;
  switch (j) {
    case 0: J.src = p.even_w_in; J.dst = (u16*)(ws + O_WIN); J.ld = 3672; J.K = 2048; J.Nd = NIN0; J.map = 1; break;
    case 1: J.src = p.even_w_out; J.dst = (u16*)(ws + O_WOUT); J.ld = 2048; J.K = 2048; J.Nd = 2048; break;
    case 2: J.src = p.cmp_w1_k; J.dst = (u16*)(ws + O_W1K); J.ld = 256; J.K = 4096; J.Nd = 256; break;
    case 3: J.src = p.cmp_w1_v; J.dst = (u16*)(ws + O_W1V); J.ld = 256; J.K = 4096; J.Nd = 256; break;
    case 4: J.src = p.cmp_w2_k; J.dst = (u16*)(ws + O_W2K); J.ld = 128; J.K = 256; J.Nd = 128; break;
    case 5: J.src = p.cmp_w2_v; J.dst = (u16*)(ws + O_W2V); J.ld = 128; J.K = 256; J.Nd = 128; break;
    case 6: J.src = p.mla_w_uq; J.dst = (u16*)(ws + O_WUQ); J.ld = 1536; J.K = 512; J.Nd = 1536; J.map = 2; J.scale = p.mla_q_norm; break;
    case 7: J.src = p.mla_w_ukv; J.dst = (u16*)(ws + O_WUKV); J.ld = 2048; J.K = 512; J.Nd = 2048; J.scale = p.mla_kv_norm; break;
    case 8: J.src = p.fox_w_in; J.dst = (u16*)(ws + O_WFIN); J.ld = 8208; J.K = 2048; J.Nd = NIN1; J.map = 3; break;
    case 9: J.src = p.fox_w_out; J.dst = (u16*)(ws + O_WFOUT); J.ld = 2048; J.K = 2048; J.Nd = 2048; break;
    case 10: J.src = p.ffn_w1; J.src2 = p.ffn_w3; J.dst = (u16*)(ws + O_W13_0); J.ld = F_; J.K = 2048; J.Nd = 2 * F_; J.map = 4; break;
    case 11: J.src = p.ffn_w1 + (size_t)2048 * F_; J.src2 = p.ffn_w3 + (size_t)2048 * F_; J.dst = (u16*)(ws + O_W13_1); J.ld = F_; J.K = 2048; J.Nd = 2 * F_; J.map = 4; break;
    case 12: J.src = p.ffn_w2; J.dst = (u16*)(ws + O_W2_0); J.ld = 2048; J.K = F_; J.Nd = 2048; break;
    default: J.src = p.ffn_w2 + (size_t)F_ * 2048; J.dst = (u16*)(ws + O_W2_1); J.ld = 2048; J.K = F_; J.Nd = 2048; break;
  }
  return J;
}

DI int map_col(int map, int n, int& which) {
  which = 0;
  switch (map) {
    case 0: return n;
    case 1: if (n < 2560) return n; if (n < 3648) return n + 24; if (n < 3672) return n - 3648 + 2560; return -1;
    case 2: if (n < 1024) return (n >> 7) * 192 + (n & 127); { int m = n - 1024; return (m >> 6) * 192 + 128 + (m & 63); }
    case 3: if (n < 6144) return n; if (n < 8192) return n + 16; if (n < 8208) return n - 8192 + 6144; return -1;
    default: { int w = n & 63; which = w >> 5; return (n >> 6) * 32 + (w & 31); }
  }
}

DI void conv_tile(const ConvJob& J, int tile, char* smem) {
  u32* st = (u32*)smem;
  const int tid = otid();
  const int ntn = J.Nd >> 7;
  const int kt = tile / ntn, nt = tile - kt * ntn;
  const int k0 = kt * 128, n0 = nt * 128;
  {
    const int n4 = tid & 31, kp = tid >> 5;
    int which; const int sc = map_col(J.map, n0 + 4 * n4, which);
    const float* src = (which ? J.src2 : J.src) + (size_t)(k0 + 2 * kp) * J.ld + (sc >= 0 ? sc : 0);
    float4 va[8], vb[8];
#pragma unroll
    for (int i = 0; i < 8; ++i) {
      if (sc >= 0) {
        const f32x4 a_ = __builtin_nontemporal_load((const f32x4*)(src + (size_t)(16 * i) * J.ld)), b_ = __builtin_nontemporal_load((const f32x4*)(src + (size_t)(16 * i + 1) * J.ld));
        va[i] = make_float4(a_.x, a_.y, a_.z, a_.w); vb[i] = make_float4(b_.x, b_.y, b_.z, b_.w);
      }
      else { va[i] = make_float4(0, 0, 0, 0); vb[i] = va[i]; }
    }
#pragma unroll
    for (int i = 0; i < 8; ++i) {
      float sa = 1.f, sb = 1.f;
      if (J.scale) { sa = J.scale[k0 + 16 * i + 2 * kp]; sb = J.scale[k0 + 16 * i + 2 * kp + 1]; }
      u32x4 w = {pack2(va[i].x * sa, vb[i].x * sb), pack2(va[i].y * sa, vb[i].y * sb), pack2(va[i].z * sa, vb[i].z * sb), pack2(va[i].w * sa, vb[i].w * sb)};
      *(u32x4*)(st + (8 * i + kp) * 132 + 4 * n4) = w;
    }
  }
  __syncthreads();
  {
    const int nr = tid & 127, kh = tid >> 7;
    const u32* sp = st + (32 * kh) * 132 + nr;
    u32x4* d = (u32x4*)(J.dst + (size_t)(n0 + nr) * J.K + k0 + 64 * kh);
#pragma unroll
    for (int j = 0; j < 8; ++j) {
      u32x4 w = {sp[(4 * j) * 132], sp[(4 * j + 1) * 132], sp[(4 * j + 2) * 132], sp[(4 * j + 3) * 132]};
      d[j] = w;
    }
  }
  __syncthreads();
}

DI void phase_prep(const Params& p, int bid, int nb, char* smem) {
  const int tid = otid();
  constexpr int N_ADA = 2 * 12 * 16, N_C1 = 2 * 64;
  const int total = N_ADA + N_C1 + CONV_TILES;
  __shared__ uint4 s_item;
  unsigned* ctr = (unsigned*)(WS(p) + O_BAR) + 9;
  (void)bid; (void)nb;
  while (true) {
    __syncthreads();
    if (threadIdx.x == 0) s_item.x = atomicAdd(ctr, 1u);
    __syncthreads();
    const int it = __builtin_amdgcn_readfirstlane((int)s_item.x);
    if (it >= total) break;
    if (it < N_ADA) {
      const int layer = it / 192, rem = it % 192, cc = rem / 16, kc = rem % 16;
      const float* w = p.ada_w + (size_t)layer * 2048 * 12288 + (size_t)(kc * 128) * 12288 + cc * 1024 + tid * 4;
      float4 acc = make_float4(0, 0, 0, 0);
#pragma unroll 16
      for (int k = 0; k < 128; ++k) {
        const float cv = siluf(p.c[kc * 128 + k]);
        const f32x4 wv = __builtin_nontemporal_load((const f32x4*)(w + (size_t)k * 12288));
        acc.x += cv * wv.x; acc.y += cv * wv.y; acc.z += cv * wv.z; acc.w += cv * wv.w;
      }
      float* mp = (float*)(WS(p) + O_MODP) + (size_t)kc * 24576 + layer * 12288 + cc * 1024 + tid * 4;
      *(float4*)mp = acc;
    } else if (it < N_ADA + N_C1) {
      const int j = it - N_ADA, which = j >> 6, kc = j & 63;
      const float* w = (which ? p.cmp_w1_v : p.cmp_w1_k) + (size_t)(kc * 64) * 256 + tid;
      const float* pe = (which ? p.cmp_pos_v : p.cmp_pos_k) + kc * 64;
      float acc = 0.f;
#pragma unroll 8
      for (int k = 0; k < 64; ++k) acc += pe[k] * __builtin_nontemporal_load(w + (size_t)k * 256);
      ((float*)(WS(p) + O_C1P))[(which * 64 + kc) * 256 + tid] = acc;
    } else {
      int t = it - N_ADA - N_C1, j = 0;
      while (t >= c_job_tiles[j]) { t -= c_job_tiles[j]; ++j; }
      conv_tile(p.jobs[j], t, smem);
    }
  }
}

DI void sincos_r(float x, float& s, float& c) {
  const float n = rintf(x * 0.15915494309189535f);
  float r = fmaf(-n, 6.28125f, x);
  r = fmaf(-n, 1.9353071795864769e-3f, r);
  s = __sinf(r); c = __cosf(r);
}

DI void phase_fin(const Params& p, int bid, int nb) {
  const int gt = bid * 256 + otid(), nt = nb * 256;
  const float* mp = (const float*)(WS(p) + O_MODP);
  float* mod = (float*)(WS(p) + O_MOD);
  for (int i = gt; i < 24576; i += nt) {
    float a = p.ada_b[i];
    for (int k = 0; k < 16; ++k) a += mp[(size_t)k * 24576 + i];
    mod[i] = a;
  }
  const float* cp = (const float*)(WS(p) + O_C1P);
  float* c1 = (float*)(WS(p) + O_C1);
  for (int i = gt; i < 512; i += nt) {
    const int which = i >> 8, j = i & 255;
    float a = 0.f;
    for (int k = 0; k < 64; ++k) a += cp[(which * 64 + k) * 256 + j];
    c1[i] = a;
  }
  float2* rt = (float2*)(WS(p) + O_ROPE);
  for (int i = gt; i < S_ * 32; i += nt) {
    const int t = i >> 5, j = i & 31;
    const float ang = (float)p.pos[t] * p.inv_freq[j];
    float s, c; sincos_r(ang, s, c);
    rt[i] = make_float2(c, s);
  }
}

DI void phase_norm(const float* xin, const float* g, const float* sc, const float* sh, u16* dstb, float* dstf, int bid, int nb) {
  const int lane = otid() & 63;
  const int gw = bid * 4 + (otid() >> 6), nw = nb * 4;
  for (int row = gw; row < S_; row += nw) {
    const float4* xr = (const float4*)(xin + (size_t)row * D_);
    float4 v[8]; float ss = 0.f;
#pragma unroll
    for (int i = 0; i < 8; ++i) { v[i] = xr[lane + 64 * i]; ss += v[i].x * v[i].x + v[i].y * v[i].y + v[i].z * v[i].z + v[i].w * v[i].w; }
#pragma unroll
    for (int o = 32; o >= 1; o >>= 1) ss += __shfl_xor(ss, o, 64);
    const float rstd = rsqrtf(ss * (1.f / D_) + 1e-6f);
#pragma unroll
    for (int i = 0; i < 8; ++i) {
      const int c0 = (lane + 64 * i) * 4;
      const float4 gv = *(const float4*)(g + c0);
      float4 y = make_float4(v[i].x * rstd * gv.x, v[i].y * rstd * gv.y, v[i].z * rstd * gv.z, v[i].w * rstd * gv.w);
      if (dstb) {
        const float4 a = *(const float4*)(sc + c0), b = *(const float4*)(sh + c0);
        y.x = y.x * (1.f + a.x) + b.x; y.y = y.y * (1.f + a.y) + b.y; y.z = y.z * (1.f + a.z) + b.z; y.w = y.w * (1.f + a.w) + b.w;
        *(uint2*)(dstb + (size_t)row * D_ + c0) = make_uint2(pack2(y.x, y.y), pack2(y.z, y.w));
      } else {
        *(float4*)(dstf + (size_t)row * D_ + c0) = y;
      }
    }
  }
}

constexpr int MB = 4, WMS = 32 * MB, BM = 2 * WMS;
constexpr int GST = 72;
constexpr int GEMM_LDS = (BM + 128) * GST * 2;
struct GemmIn { const u16* A; long lda; int mclamp; const u16* Bt; long ldb; int K; };

DI void gemm_tile(const GemmIn& g, int m0, int n0, char* smem, f32x16 (&acc)[MB][2]) {
  u16* sA = (u16*)smem; u16* sB = sA + BM * GST;
  const int tid = otid(), wave = tid >> 6, lane = tid & 63, r = lane & 31, h = lane >> 5, wm = wave >> 1, wn = wave & 1;
#pragma unroll
  for (int a = 0; a < MB; ++a)
#pragma unroll
    for (int b = 0; b < 2; ++b)
#pragma unroll
      for (int i = 0; i < 16; ++i) acc[a][b][i] = 0.f;
  const int lrow = tid >> 3, lkc = (tid & 7) * 8;
  const unsigned ago = (unsigned)opq((m0 + lrow) * (int)g.lda + lkc), bgo = (unsigned)opq((n0 + lrow) * (int)g.ldb + lkc);
  const int lo = opq(lrow * GST + lkc);
  u32x4 ra[8], rb[4];
  const int nk = g.K >> 6;
#pragma unroll
  for (int i = 0; i < 8; ++i) ra[i] = *(const u32x4*)(g.A + (size_t)(32 * i) * g.lda + ago);
#pragma unroll
  for (int i = 0; i < 4; ++i) rb[i] = *(const u32x4*)(g.Bt + (size_t)(32 * i) * g.ldb + bgo);
  const int aoff = opq((WMS * wm + r) * GST + 8 * h), boff = opq((64 * wn + r) * GST + 8 * h);
  for (int kt = 0; kt < nk; ++kt) {
    __syncthreads();
#pragma unroll
    for (int i = 0; i < 8; ++i) *(u32x4*)(sA + lo + 32 * i * GST) = ra[i];
#pragma unroll
    for (int i = 0; i < 4; ++i) *(u32x4*)(sB + lo + 32 * i * GST) = rb[i];
    __syncthreads();
    if (kt + 1 < nk) {
#pragma unroll
      for (int i = 0; i < 8; ++i) ra[i] = *(const u32x4*)(g.A + ((size_t)(32 * i) * g.lda + (kt + 1) * 64) + ago);
#pragma unroll
      for (int i = 0; i < 4; ++i) rb[i] = *(const u32x4*)(g.Bt + ((size_t)(32 * i) * g.ldb + (kt + 1) * 64) + bgo);
    }
#pragma unroll
    for (int ks = 0; ks < 4; ++ks) {
      bf16x8 af[MB], bf[2];
#pragma unroll
      for (int mb = 0; mb < MB; ++mb) af[mb] = *(const bf16x8*)(sA + aoff + 32 * mb * GST + 16 * ks);
#pragma unroll
      for (int nb2 = 0; nb2 < 2; ++nb2) bf[nb2] = *(const bf16x8*)(sB + boff + 32 * nb2 * GST + 16 * ks);
#pragma unroll
      for (int mb = 0; mb < MB; ++mb)
#pragma unroll
        for (int nb2 = 0; nb2 < 2; ++nb2) acc[mb][nb2] = MFMA32(af[mb], bf[nb2], acc[mb][nb2]);
    }
  }
  __syncthreads();
}

DI bool tile_coord(int it, int bid, int nb, int MT, int NT, int& mt, int& nt) {
  const int per = nb >> 3;
  const int idx = (it * 8 + (bid & 7)) * per + (bid >> 3);
  if (idx >= MT * NT) return false;
  const int pfull = 8 * MT;
  const int pnl = idx / pfull;
  const int rem = idx - pnl * pfull;
  const int left = NT - pnl * 8;
  if (left >= 8) { mt = rem >> 3; nt = pnl * 8 + (rem & 7); }
  else { mt = rem / left; nt = pnl * 8 + rem % left; }
  return true;
}

DI void store_bf16(const f32x16 (&acc)[MB][2], u16* dst, int ld, int wm, int wn, int r, int h, float rs_mul = 1.f) {
  u16* b = dst + opq((WMS * wm + 4 * h) * ld + 64 * wn + r);
#pragma unroll
  for (int mb = 0; mb < MB; ++mb)
#pragma unroll
    for (int nb2 = 0; nb2 < 2; ++nb2)
#pragma unroll
      for (int i = 0; i < 16; ++i) b[(32 * mb + crow0(i)) * ld + 32 * nb2] = f2bf(acc[mb][nb2][i] * rs_mul);
}
DI void store_bf16_t(const f32x16 (&acc)[MB][2], u16* dst, int ldt, int wm, int wn, int r, int h) {
  u16* b = dst + opq((64 * wn + r) * ldt + WMS * wm + 4 * h);
#pragma unroll
  for (int mb = 0; mb < MB; ++mb)
#pragma unroll
    for (int nb2 = 0; nb2 < 2; ++nb2)
#pragma unroll
      for (int q = 0; q < 4; ++q)
        *(uint2*)(b + 32 * nb2 * ldt + 32 * mb + 8 * q) = make_uint2(pack2(acc[mb][nb2][4 * q], acc[mb][nb2][4 * q + 1]), pack2(acc[mb][nb2][4 * q + 2], acc[mb][nb2][4 * q + 3]));
}

#define WAVE_IDS const int tid = otid(), wave = tid >> 6, lane = tid & 63, r = lane & 31, h = lane >> 5, wm = wave >> 1, wn = wave & 1; (void)tid; (void)wm; (void)wn; (void)r; (void)h;

DI void phase_even_in(const Params& p, int bid, int nb, char* smem) {
  WAVE_IDS
  char* ws = WS(p);
  GemmIn g{(const u16*)(ws + O_H), D_, S_ - 1, (const u16*)(ws + O_WIN), D_, D_};
  const float2* rt = (const float2*)(ws + O_ROPE);
  for (int it = 0;; ++it) {
    int mt, nt; if (!tile_coord(it, bid, nb, S_ / BM, 29, mt, nt)) break;
    f32x16 acc[MB][2];
    const int m0 = mt * BM;
    gemm_tile(g, m0, nt * 128, smem, acc);
    if (nt < 8) store_bf16(acc, (u16*)(ws + O_QN) + ((size_t)nt * S_ + m0) * 128, 128, wm, wn, r, h);
    else if (nt < 20) {
      const int c = nt - 8, br = c >> 2, kv = (c >> 1) & 1, gq = c & 1;
      if (br == 0) store_bf16(acc, (u16*)(ws + (kv ? O_VCS : O_KCS)) + ((size_t)gq * S_ + m0) * 128, 128, wm, wn, r, h);
      else if (kv == 0) store_bf16(acc, (u16*)(ws + (br == 1 ? O_KS : O_KW)) + ((size_t)gq * S_ + m0) * 128, 128, wm, wn, r, h);
      else store_bf16_t(acc, (u16*)(ws + (br == 1 ? O_VST : O_VWT)) + (size_t)gq * 128 * S_ + m0, S_, wm, wn, r, h);
    } else if (nt < 24) store_bf16(acc, (u16*)(ws + O_CQ) + (size_t)m0 * 512 + (nt - 20) * 128, 512, wm, wn, r, h);
    else if (nt < 28) store_bf16(acc, (u16*)(ws + O_CKV) + (size_t)m0 * 512 + (nt - 24) * 128, 512, wm, wn, r, h);
    else {
      float* kraw = (float*)(ws + O_KRAW) + opq((m0 + WMS * wm + 4 * h) * 88 + 64 * wn + r);
#pragma unroll
      for (int mb = 0; mb < MB; ++mb)
#pragma unroll
        for (int nb2 = 0; nb2 < 2; ++nb2)
          if (64 * wn + 32 * nb2 + r < 88) {
#pragma unroll
            for (int i = 0; i < 16; ++i) kraw[(32 * mb + crow0(i)) * 88 + 32 * nb2] = acc[mb][nb2][i];
          }
    }
  }
}

DI void rowscale_512(const u16* A, int m0, float* srs) {
  const int tid = otid();
  const u32x4* ar = (const u32x4*)(A + (size_t)(m0 + tid) * 512);
  float ss = 0.f;
#pragma unroll 8
  for (int i = 0; i < 64; ++i) {
    const u32x4 v = ar[i];
#pragma unroll
    for (int j = 0; j < 4; ++j) { const float a = __uint_as_float(v[j] << 16), b = __uint_as_float(v[j] & 0xffff0000u); ss += a * a + b * b; }
  }
  srs[tid] = rsqrtf(ss * (1.f / 512.f) + 1e-6f);
}

DI void phase_mla_up(const Params& p, int bid, int nb, char* smem) {
  WAVE_IDS
  char* ws = WS(p);
  float* srs = (float*)(smem + GEMM_LDS);
  const float2* rt = (const float2*)(ws + O_ROPE);
  {
    const float* kraw = (const float*)(ws + O_KRAW);
    u16* km = (u16*)(ws + O_KM);
    float* gt = (float*)(ws + O_GATES);
    for (int i = bid * 256 + tid; i < S_ * 32; i += nb * 256) {
      const int t = i >> 5, j = i & 31;
      const float x1 = kraw[t * 88 + j], x2 = kraw[t * 88 + 32 + j];
      const float2 cs = rt[i];
      const u16 o1 = f2bf(x1 * cs.x - x2 * cs.y), o2 = f2bf(x1 * cs.y + x2 * cs.x);
#pragma unroll
      for (int hd = 0; hd < 8; ++hd) { u16* d = km + ((size_t)hd * S_ + t) * 192 + 128 + j; d[0] = o1; d[32] = o2; }
      if (j < 24) gt[t * 24 + j] = sigmoidf(kraw[t * 88 + 64 + j] + p.gate_b[j]);
    }
  }
  if (bid < 64) {
    const int ks = bid >> 4, which = (bid >> 3) & 1, gq = (bid >> 2) & 1, mt = (bid >> 1) & 1, nt = bid & 1;
    GemmIn g{(const u16*)(ws + (which ? O_VCS : O_KCS)) + (size_t)gq * S_ * 128 + ks * 1024, 2048, 510, (const u16*)(ws + (which ? O_W1V : O_W1K)) + ks * 1024, 4096, 1024};
    f32x16 acc[MB][2];
    gemm_tile(g, mt * BM, nt * 128, smem, acc);
    float* dst = (float*)(ws + O_HCP) + ((size_t)((ks * 2 + which) * 2 + gq) * 512 + mt * BM) * 256 + nt * 128 + opq((WMS * wm + 4 * h) * 256 + 64 * wn + r);
#pragma unroll
    for (int mb = 0; mb < MB; ++mb)
#pragma unroll
      for (int nb2 = 0; nb2 < 2; ++nb2)
#pragma unroll
        for (int i = 0; i < 16; ++i) dst[(32 * mb + crow0(i)) * 256 + 32 * nb2] = acc[mb][nb2][i];
    return;
  }
  const int vb = bid - 64, vn = nb - 64;
  constexpr int MTS = S_ / BM;
  const int total = MTS * 12 + MTS * 16;
  for (int t = vb; t < total; t += vn) {
    f32x16 acc[MB][2];
    if (t < MTS * 12) {
      const int nt = t / MTS, mt = t % MTS, m0 = mt * BM;
      __syncthreads();
      rowscale_512((const u16*)(ws + O_CQ), m0, srs);
      GemmIn g{(const u16*)(ws + O_CQ), 512, S_ - 1, (const u16*)(ws + O_WUQ), 512, 512};
      gemm_tile(g, m0, nt * 128, smem, acc);
      u16* qm = (u16*)(ws + O_QM);
      const float* srb = srs + opq(WMS * wm + 4 * h);
      if (nt < 8) {
        u16* d = qm + (size_t)nt * S_ * 192 + opq((m0 + WMS * wm + 4 * h) * 192 + 64 * wn + r);
#pragma unroll
        for (int mb = 0; mb < MB; ++mb)
#pragma unroll
          for (int i = 0; i < 16; ++i) {
            const int rl = 32 * mb + crow0(i); const float rs = srb[rl];
#pragma unroll
            for (int nb2 = 0; nb2 < 2; ++nb2) d[rl * 192 + 32 * nb2] = f2bf(acc[mb][nb2][i] * rs);
          }
      } else {
        const int hd = 2 * (nt - 8) + wn;
        u16* d = qm + (size_t)hd * S_ * 192 + opq((m0 + WMS * wm + 4 * h) * 192 + 128 + r);
        const float2* rb = rt + opq((m0 + WMS * wm + 4 * h) * 32 + r);
#pragma unroll
        for (int mb = 0; mb < MB; ++mb) {
          float2 csv[16];
#pragma unroll
          for (int i = 0; i < 16; ++i) csv[i] = rb[(32 * mb + crow0(i)) * 32];
#pragma unroll
          for (int i = 0; i < 16; ++i) {
            const int rl = 32 * mb + crow0(i); const float rs = srb[rl];
            const float2 cs = csv[i];
            const float x1 = acc[mb][0][i] * rs, x2 = acc[mb][1][i] * rs;
            d[rl * 192] = f2bf(x1 * cs.x - x2 * cs.y); d[rl * 192 + 32] = f2bf(x1 * cs.y + x2 * cs.x);
          }
        }
      }
    } else {
      const int t2 = t - MTS * 12, nt = t2 / MTS, mt = t2 % MTS, m0 = mt * BM;
      __syncthreads();
      rowscale_512((const u16*)(ws + O_CKV), m0, srs);
      GemmIn g{(const u16*)(ws + O_CKV), 512, S_ - 1, (const u16*)(ws + O_WUKV), 512, 512};
      gemm_tile(g, m0, nt * 128, smem, acc);
      const int hd = nt >> 1;
#pragma unroll
      for (int mb = 0; mb < MB; ++mb)
#pragma unroll
        for (int i = 0; i < 16; ++i) { const float rs = srs[opq(WMS * wm + 4 * h) + 32 * mb + crow0(i)]; acc[mb][0][i] *= rs; acc[mb][1][i] *= rs; }
      if ((nt & 1) == 0) store_bf16(acc, (u16*)(ws + O_KM) + ((size_t)hd * S_ + m0) * 192, 192, wm, wn, r, h);
      else store_bf16_t(acc, (u16*)(ws + O_VMT) + (size_t)hd * 128 * S_ + m0, S_, wm, wn, r, h);
    }
  }
}

DI void phase_cmp_out(const Params& p, int bid, int nb, char* smem) {
  WAVE_IDS
  char* ws = WS(p);
  for (int t = bid; t < 8; t += nb) {
    const int which = t >> 2, gq = (t >> 1) & 1, mt = t & 1;
    {
      const float* hp = (const float*)(ws + O_HCP) + ((size_t)(which * 2 + gq) * 512 + mt * BM) * 256;
      const float* c1 = (const float*)(ws + O_C1) + which * 256;
      u16* hc = (u16*)(ws + O_HC) + ((size_t)(which * 2 + gq) * 512 + mt * BM) * 256;
      const float4 cb = *(const float4*)(c1 + ((tid * 4) & 255));
      for (int e0 = tid * 4; e0 < BM * 256; e0 += 256 * 4 * 8) {
        float4 a[8];
#pragma unroll
        for (int u = 0; u < 8; ++u) a[u] = *(const float4*)(hp + e0 + u * 1024);
#pragma unroll
        for (int ks = 1; ks < 4; ++ks)
#pragma unroll
          for (int u = 0; u < 8; ++u) { const float4 b = *(const float4*)(hp + (size_t)ks * 4 * 512 * 256 + e0 + u * 1024); a[u].x += b.x; a[u].y += b.y; a[u].z += b.z; a[u].w += b.w; }
#pragma unroll
        for (int u = 0; u < 8; ++u)
          *(uint2*)(hc + e0 + u * 1024) = make_uint2(pack2(siluf(a[u].x + cb.x), siluf(a[u].y + cb.y)), pack2(siluf(a[u].z + cb.z), siluf(a[u].w + cb.w)));
      }
      __threadfence();
      __syncthreads();
    }
    GemmIn g{(const u16*)(ws + O_HC) + (size_t)(which * 2 + gq) * 512 * 256, 256, 511, (const u16*)(ws + (which ? O_W2V : O_W2K)), 256, 256};
    f32x16 acc[MB][2];
    gemm_tile(g, mt * BM, 0, smem, acc);
    if (which == 0) store_bf16(acc, (u16*)(ws + O_KC) + ((size_t)gq * 512 + mt * BM) * 128, 128, wm, wn, r, h);
    else store_bf16_t(acc, (u16*)(ws + O_VCT) + (size_t)gq * 128 * 512 + mt * BM, 512, wm, wn, r, h);
  }
}

DI void phase_resid(const Params& p, const u16* A, int K, const u16* Bt, const float* xin, const float* gate, float* xout, int bid, int nb, char* smem) {
  WAVE_IDS
  GemmIn g{A, K, S_ - 1, Bt, K, K};
  for (int it = 0;; ++it) {
    int mt, nt; if (!tile_coord(it, bid, nb, S_ / BM, 16, mt, nt)) break;
    f32x16 acc[MB][2];
    const int m0 = mt * BM, n0 = nt * 128;
    gemm_tile(g, m0, n0, smem, acc);
    const int ob = opq((m0 + WMS * wm + 4 * h) * D_ + n0 + 64 * wn + r);
    const float* xi = xin + ob; float* xo = xout + ob;
#pragma unroll
    for (int mb = 0; mb < MB; ++mb)
#pragma unroll
      for (int nb2 = 0; nb2 < 2; ++nb2) {
        const float gv = gate[n0 + 64 * wn + 32 * nb2 + r];
        float xv[16];
#pragma unroll
        for (int i = 0; i < 16; ++i) xv[i] = xi[(32 * mb + crow0(i)) * D_ + 32 * nb2];
#pragma unroll
        for (int i = 0; i < 16; ++i) xo[(32 * mb + crow0(i)) * D_ + 32 * nb2] = xv[i] + gv * acc[mb][nb2][i];
      }
  }
}

DI void phase_ffn_up(const Params& p, const u16* W13, int bid, int nb, char* smem) {
  WAVE_IDS
  GemmIn g{(const u16*)(WS(p) + O_H), D_, S_ - 1, W13, D_, D_};
  u16* U = (u16*)(WS(p) + O_U);
  for (int it = 0;; ++it) {
    int mt, nt; if (!tile_coord(it, bid, nb, S_ / BM, 88, mt, nt)) break;
    f32x16 acc[MB][2];
    const int m0 = mt * BM;
    gemm_tile(g, m0, nt * 128, smem, acc);
    u16* ub = U + (size_t)m0 * F_ + opq((WMS * wm + 4 * h) * F_ + 32 * (2 * nt + wn) + r);
#pragma unroll
    for (int mb = 0; mb < MB; ++mb)
#pragma unroll
      for (int i = 0; i < 16; ++i) ub[(32 * mb + crow0(i)) * F_] = f2bf(siluf(acc[mb][0][i]) * acc[mb][1][i]);
  }
}

DI void phase_fox_in(const Params& p, int bid, int nb, char* smem) {
  WAVE_IDS
  char* ws = WS(p);
  float* red = (float*)(smem + GEMM_LDS);
  GemmIn g{(const u16*)(ws + O_H), D_, S_ - 1, (const u16*)(ws + O_WFIN), D_, D_};
  for (int it = 0;; ++it) {
    int mt, nt; if (!tile_coord(it, bid, nb, S_ / BM, 64, mt, nt)) break;
    f32x16 acc[MB][2];
    const int m0 = mt * BM;
    gemm_tile(g, m0, nt * 128, smem, acc);
    if (nt < 32) {
      const float* gn = (nt < 16) ? p.fox_q_norm : p.fox_k_norm;
#pragma unroll
      for (int mb = 0; mb < MB; ++mb)
#pragma unroll
        for (int i = 0; i < 16; ++i) {
          if ((i & 3) == 0) SB0;
          float ss = acc[mb][0][i] * acc[mb][0][i] + acc[mb][1][i] * acc[mb][1][i];
#pragma unroll
          for (int o = 16; o >= 1; o >>= 1) ss += __shfl_xor(ss, o, 64);
          if (r == 0) red[opq(wn * BM + WMS * wm + 4 * h) + 32 * mb + crow0(i)] = ss;
        }
      __syncthreads();
      const float g0 = gn[64 * wn + r], g1 = gn[64 * wn + 32 + r];
      u16* dst = (u16*)(ws + (nt < 16 ? O_QF : O_KF)) + ((size_t)(nt & 15) * S_ + m0) * 128 + opq((WMS * wm + 4 * h) * 128 + 64 * wn + r);
      const float* rdb = red + opq(WMS * wm + 4 * h);
#pragma unroll
      for (int mb = 0; mb < MB; ++mb)
#pragma unroll
        for (int i = 0; i < 16; ++i) {
          const int rl = 32 * mb + crow0(i);
          const float rstd = rsqrtf((rdb[rl] + rdb[BM + rl]) * (1.f / 128.f) + 1e-6f);
          dst[rl * 128] = f2bf(acc[mb][0][i] * rstd * g0);
          dst[rl * 128 + 32] = f2bf(acc[mb][1][i] * rstd * g1);
        }
      __syncthreads();
    } else if (nt < 48) store_bf16_t(acc, (u16*)(ws + O_VFT) + (size_t)(nt - 32) * 128 * S_ + m0, S_, wm, wn, r, h);
    else store_bf16(acc, (u16*)(ws + O_OG) + (size_t)m0 * D_ + (nt - 48) * 128, D_, wm, wn, r, h);
  }
  for (int e = bid; e < 4 * (S_ / BM); e += nb) {
    const int mt = e >> 2, ks = e & 3, m0 = mt * BM;
    GemmIn gf{(const u16*)(ws + O_H) + ks * 512, D_, S_ - 1, (const u16*)(ws + O_WFIN) + (size_t)8192 * D_ + ks * 512, D_, 512};
    f32x16 acc[MB][2];
    gemm_tile(gf, m0, 0, smem, acc);
    if (wn == 0 && r < 16) {
      float* fl = (float*)(ws + O_FL) + (size_t)ks * S_ * 16 + opq((m0 + WMS * wm + 4 * h) * 16 + r);
#pragma unroll
      for (int mb = 0; mb < MB; ++mb)
#pragma unroll
        for (int i = 0; i < 16; ++i) fl[(32 * mb + crow0(i)) * 16] = acc[mb][0][i];
    }
  }
}

DI void phase_cumsum(const Params& p, int bid, int nb, char* smem) {
  float* sw = (float*)smem;
  const int tid = otid(), lane = tid & 63, wave = tid >> 6;
  const float* fl = (const float*)(WS(p) + O_FL);
  for (int hd = bid; hd < 16; hd += nb) {
    float v[32]; float s = 0.f;
    const float fb = p.fox_f_b[hd];
#pragma unroll
    for (int i = 0; i < 32; ++i) {
      const size_t o = (size_t)(tid * 32 + i) * 16 + hd;
      const float z = ((fl[o] + fl[o + (size_t)S_ * 16]) + (fl[o + (size_t)2 * S_ * 16] + fl[o + (size_t)3 * S_ * 16])) + fb;
      s += fminf(z, 0.f) - __logf(1.f + __expf(-fabsf(z)));
      v[i] = s;
    }
    float inc = s;
#pragma unroll
    for (int o = 1; o < 64; o <<= 1) { const float t = __shfl_up(inc, o, 64); if (lane >= o) inc += t; }
    __syncthreads();
    if (lane == 63) sw[wave] = inc;
    __syncthreads();
    float base = inc - s;
    for (int w = 0; w < wave; ++w) base += sw[w];
    float* cum = (float*)(WS(p) + O_CUM) + (size_t)hd * S_ + tid * 32;
#pragma unroll
    for (int i = 0; i < 32; ++i) cum[i] = base + v[i];
  }
}

constexpr int VST = 68;
enum { MODE_WIN = 0, MODE_SEL = 1, MODE_MLA = 2, MODE_FOX = 3, MODE_CMP = 4 };

template <int DQK>
DI void load_k_tile(const u16* K, int key0, u16* sK) {
  constexpr int KST = DQK + 8;
  const int tid = otid();
  const u16* gp = K + (size_t)key0 * DQK + opq((tid >> 3) * DQK + (tid & 7) * 8);
  u16* lp = sK + opq((tid >> 3) * KST + (tid & 7) * 8);
#pragma unroll
  for (int i = 0; i < DQK / 32; ++i)
    *(u32x4*)(lp + 32 * (i & 1) * KST + 64 * (i >> 1)) = *(const u32x4*)(gp + 32 * (i & 1) * DQK + 64 * (i >> 1));
}
DI void load_vt_tile(const u16* Vt, int ldv, int key0, u16* sV) {
  const int tid = otid();
  const u16* gp = Vt + key0 + opq((tid >> 3) * ldv + (tid & 7) * 8);
  u16* lp = sV + opq((tid >> 3) * VST + (tid & 7) * 8);
#pragma unroll
  for (int i = 0; i < 4; ++i) {
    const u32x4 v = *(const u32x4*)(gp + 32 * i * ldv);
    *(u32x2*)(lp + 32 * i * VST) = u32x2{v.x, v.y};
    *(u32x2*)(lp + 32 * i * VST + 4) = u32x2{v.z, v.w};
  }
}
template <int DQK>
DI void qk_tile(const u16* sK, const bf16x8 (&qf)[DQK / 16], f32x16 (&s)[2], int r, int h) {
  constexpr int KST = DQK + 8;
  constexpr int NKS = DQK / 16;
  const u16* kp = sK + opq(r * KST + 8 * h);
#pragma unroll
  for (int kb = 0; kb < 2; ++kb) {
#pragma unroll
    for (int i = 0; i < 16; ++i) s[kb][i] = 0.f;
#pragma unroll
    for (int c0 = 0; c0 < NKS; c0 += 8) {
      constexpr int CH = 8;
      bf16x8 kf[CH];
#pragma unroll
      for (int j = 0; j < CH; ++j) if (c0 + j < NKS) kf[j] = *(const bf16x8*)(kp + 32 * kb * KST + 16 * (c0 + j));
      SB0;
#pragma unroll
      for (int j = 0; j < CH; ++j) if (c0 + j < NKS) s[kb] = MFMA32(kf[j], qf[c0 + j], s[kb]);
    }
  }
}
DI void pv_tile(const u16* sV, const f32x16 (&s)[2], f32x16 (&o)[4], int r, int h) {
  const u16* vb = sV + opq(r * VST + 4 * h);
#pragma unroll
  for (int kb = 0; kb < 2; ++kb) {
    bf16x8 pf[2]; bf16x8 vf[2][4];
#pragma unroll
    for (int s2 = 0; s2 < 2; ++s2) {
      pf[s2] = pack8(s[kb], s2);
#pragma unroll
      for (int db = 0; db < 4; ++db) {
        const u16* vp = vb + 32 * db * VST + 32 * kb + 16 * s2;
        const s16x4 lo = *(const s16x4*)vp, hi = *(const s16x4*)(vp + 8);
        vf[s2][db] = __builtin_shufflevector(lo, hi, 0, 1, 2, 3, 4, 5, 6, 7);
      }
    }
    SB0;
#pragma unroll
    for (int s2 = 0; s2 < 2; ++s2)
#pragma unroll
      for (int db = 0; db < 4; ++db) o[db] = MFMA32(vf[s2][db], pf[s2], o[db]);
  }
}

DI void topk_item(const Params& p, int qt, int gq) {
  WAVE_IDS
  char* ws = WS(p);
  const int tq = qt * 128 + wave * 32 + r;
  const int head = gq * 4;
  u32 selw[4] = {0, 0, 0, 0};
    float A[64];
    {
      const float* ib = (const float*)(ws + O_IMP) + (((size_t)(head & ~3) * S_ + tq) * 2 + h) * 64;
#pragma unroll
      for (int j = 0; j < 16; ++j) { const float4 v = *(const float4*)(ib + 4 * j); A[4 * j] = v.x; A[4 * j + 1] = v.y; A[4 * j + 2] = v.z; A[4 * j + 3] = v.w; }
#pragma unroll 1
      for (int rr = 1; rr < 4; ++rr) {
        const float* ib2 = ib + (size_t)rr * S_ * 128;
#pragma unroll
        for (int j = 0; j < 16; ++j) { const float4 v = *(const float4*)(ib2 + 4 * j); A[4 * j] += v.x; A[4 * j + 1] += v.y; A[4 * j + 2] += v.z; A[4 * j + 3] += v.w; }
      }
    }
    const int cur = tq >> 6;
    const int lim2 = opq(cur - 2 - h);
#pragma unroll
    for (int si = 0; si < 64; ++si) { if ((si == 0 && h == 0) || (2 * si > lim2)) A[si] = -3e38f; }
    auto setbit = [&](int J) { const u32 b = 1u << (J & 31); const int w = J >> 5; if (w == 0) selw[0] |= b; else if (w == 1) selw[1] |= b; else if (w == 2) selw[2] |= b; else selw[3] |= b; };
    setbit(0); setbit(cur); if (cur >= 1) setbit(cur - 1);
    for (int round = 0; round < 13; ++round) {
      float best = -3e38f; int bi = 0;
#pragma unroll
      for (int si = 0; si < 64; ++si) { if (A[si] > best) { best = A[si]; bi = si; } }
      const int bj = 2 * bi + h;
      const float ob = shx32(best); const int oj = __shfl_xor(bj, 32, 64);
      const bool takeo = (ob > best) || (ob == best && oj < bj);
      const float wv = takeo ? ob : best; const int wj = takeo ? oj : bj;
      if (wv > -1e30f) {
        setbit(wj);
        if (!takeo) {
#pragma unroll
          for (int si = 0; si < 64; ++si) if (si == bi) A[si] = -3e38f;
        }
      }
    }
    if (h == 0) *(uint4*)((u32*)(ws + O_SELM) + ((size_t)gq * S_ + tq) * 4) = make_uint4(selw[0], selw[1], selw[2], selw[3]);
}

DI int next_sel(const u32* sun, int kt, int kt_hi) {
  int k = kt + 1;
  while (k < kt_hi) {
    const u32 w = __builtin_amdgcn_readfirstlane(sun[k >> 5]) >> (k & 31);
    if (w) return k + __builtin_ctz(w);
    k = (k | 31) + 1;
  }
  return kt_hi;
}

template <int MODE>
DI void attn_item(const Params& p, int qt, int head, char* smem) {
  constexpr int DQK = (MODE == MODE_MLA) ? 192 : 128;
  constexpr int KST = DQK + 8;
  constexpr int NI = DQK / 32;
  constexpr bool HAS_T5 = (MODE == MODE_WIN || MODE == MODE_SEL || MODE == MODE_CMP);
  constexpr bool HAS_AUX = HAS_T5 || MODE == MODE_FOX;
  u16* sK = (u16*)smem; u16* sV = sK + 64 * KST;
  int* spos = (int*)(sV + 128 * VST);
  float* stbl = (float*)(spos + 64);
  int* sthr = (int*)(stbl + 32);
  u32* sun = (u32*)(sthr + 32);
  int* smm = (int*)(sun + 4);
  u32* ssel = (u32*)(smm + 4);
  WAVE_IDS
  char* ws = WS(p);
  const int qs = qt * 128, tq = qs + wave * 32 + r;
  const u16 *Q, *K, *Vt; float sc2; int ldv = S_;
  if (MODE == MODE_WIN) { Q = (const u16*)(ws + O_QN) + (size_t)head * S_ * 128; K = (const u16*)(ws + O_KW) + (size_t)(head >> 2) * S_ * 128; Vt = (const u16*)(ws + O_VWT) + (size_t)(head >> 2) * 128 * S_; sc2 = 0.08838834764831845f * LOG2E; }
  else if (MODE == MODE_SEL) { Q = (const u16*)(ws + O_QN) + (size_t)head * S_ * 128; K = (const u16*)(ws + O_KS) + (size_t)(head >> 2) * S_ * 128; Vt = (const u16*)(ws + O_VST) + (size_t)(head >> 2) * 128 * S_; sc2 = 0.08838834764831845f * LOG2E; }
  else if (MODE == MODE_CMP) { Q = (const u16*)(ws + O_QN) + (size_t)head * S_ * 128; K = (const u16*)(ws + O_KC) + (size_t)(head >> 2) * 512 * 128; Vt = (const u16*)(ws + O_VCT) + (size_t)(head >> 2) * 128 * 512; sc2 = 0.08838834764831845f * LOG2E; ldv = 512; }
  else if (MODE == MODE_MLA) { Q = (const u16*)(ws + O_QM) + (size_t)head * S_ * 192; K = (const u16*)(ws + O_KM) + (size_t)head * S_ * 192; Vt = (const u16*)(ws + O_VMT) + (size_t)head * 128 * S_; sc2 = 0.07216878364870322f * LOG2E; }
  else { Q = (const u16*)(ws + O_QF) + (size_t)head * S_ * 128; K = (const u16*)(ws + O_KF) + (size_t)head * S_ * 128; Vt = (const u16*)(ws + O_VFT) + (size_t)head * 128 * S_; sc2 = 0.08838834764831845f * LOG2E; }

  __syncthreads();
  if (HAS_T5 && tid < 32) { stbl[tid] = p.rel_bias[tid * 8 + head] * LOG2E; sthr[tid] = p.t5thr[tid]; }
  u32 selw[4] = {0, 0, 0, 0};
  if (MODE == MODE_SEL) {
    if (tid < 4) sun[tid] = 0;
    { const uint4 m4 = *(const uint4*)((const u32*)(ws + O_SELM) + ((size_t)(head >> 2) * S_ + tq) * 4); selw[0] = m4.x; selw[1] = m4.y; selw[2] = m4.z; selw[3] = m4.w; }
    __syncthreads();
    if (h == 0) { atomicOr(&sun[0], selw[0]); atomicOr(&sun[1], selw[1]); atomicOr(&sun[2], selw[2]); atomicOr(&sun[3], selw[3]); }
    ssel[tid] = selw[0]; ssel[256 + tid] = selw[1]; ssel[512 + tid] = selw[2]; ssel[768 + tid] = selw[3];
  }
  bf16x8 qf[DQK / 16];
#pragma unroll
  for (int ks = 0; ks < DQK / 16; ++ks) qf[ks] = *(const bf16x8*)(Q + (size_t)tq * DQK + 16 * ks + 8 * h);
  const int pq = HAS_T5 ? p.pos[tq] : 0;
  f32x16 o[4];
#pragma unroll
  for (int db = 0; db < 4; ++db)
#pragma unroll
    for (int i = 0; i < 16; ++i) o[db][i] = 0.f;
  float m = NEGB, l = 0.f;
  int kt_lo = 0; int kt_hi = (qs + 128) >> 6;
  if (MODE == MODE_WIN) { kt_lo = (qs - 512) >> 6; kt_lo = kt_lo < 0 ? 0 : kt_lo; }
  if (MODE == MODE_CMP) { const int tmax = qs + 127; const int nvis = ((tmax - 31) >> 4) + 1; kt_hi = (nvis + 63) >> 6; }
  __syncthreads();

  const int kgo = opq((tid >> 3) * DQK + (tid & 7) * 8), klo = opq((tid >> 3) * KST + (tid & 7) * 8);
  const int vgo = opq((tid >> 3) * ldv + (tid & 7) * 8), vlo = opq((tid >> 3) * VST + (tid & 7) * 8);
  u32x4 kreg[NI], vreg[4]; int areg = 0;
  auto issue = [&](int kt, bool withV = true) __attribute__((always_inline)) {
    const u16* gk = K + (size_t)kt * 64 * DQK + kgo;
#pragma unroll
    for (int i = 0; i < NI; ++i) kreg[i] = *(const u32x4*)(gk + 32 * (i & 1) * DQK + 64 * (i >> 1));
    if (withV) {
      const u16* gv = Vt + kt * 64 + vgo;
#pragma unroll
      for (int i = 0; i < 4; ++i) vreg[i] = *(const u32x4*)(gv + 32 * i * ldv);
    }
    if (HAS_AUX && tid < 64) {
      if (MODE == MODE_CMP) { int idx = 16 * (kt * 64 + tid) + 31; idx = idx > S_ - 1 ? S_ - 1 : idx; areg = p.pos[idx]; }
      else if (MODE == MODE_FOX) areg = __float_as_int(-LOG2E * ((const float*)(ws + O_CUM))[(size_t)head * S_ + kt * 64 + tid]);
      else areg = p.pos[kt * 64 + tid];
    }
  };
  auto stash = [&](bool withV = true) __attribute__((always_inline)) {
#pragma unroll
    for (int i = 0; i < NI; ++i) *(u32x4*)(sK + klo + 32 * (i & 1) * KST + 64 * (i >> 1)) = kreg[i];
    if (withV) {
#pragma unroll
      for (int i = 0; i < 4; ++i) { *(u32x2*)(sV + vlo + 32 * i * VST) = u32x2{vreg[i].x, vreg[i].y}; *(u32x2*)(sV + vlo + 32 * i * VST + 4) = u32x2{vreg[i].z, vreg[i].w}; }
    }
    if (HAS_AUX && tid < 64) {
      spos[tid] = areg;
      if (HAS_T5) {
        int mn = areg, mx = areg;
#pragma unroll
        for (int o2 = 32; o2 >= 1; o2 >>= 1) { mn = min(mn, __shfl_xor(mn, o2, 64)); mx = max(mx, __shfl_xor(mx, o2, 64)); }
        if (tid == 0) { smm[0] = mn; smm[1] = mx; }
      }
    }
  };
  auto logits = [&](f32x16 (&s)[2], int kt, bool mysel, bool full) __attribute__((always_inline)) {
    qk_tile<DQK>(sK, qf, s, r, h);
    const int k0 = kt * 64;
    const int rel = (MODE == MODE_CMP) ? opq(tq - 31 - 16 * (k0 + 4 * h)) : opq(tq - k0 - 4 * h);
    const int* sposb = spos + opq(4 * h);
    bool fast = false; int thr = 0; float tb0 = 0.f, tb1 = 0.f;
    if (HAS_T5) {
      const int b0 = t5_bucket(pq - smm[1]), b1 = t5_bucket(pq - smm[0]);
      fast = (__ballot((b1 - b0) > 1) == 0ull);
      thr = sthr[b1]; tb0 = stbl[b0]; tb1 = stbl[b1];
    }
    if (HAS_T5 && !fast) {
#pragma unroll
      for (int kb = 0; kb < 2; ++kb)
#pragma unroll
        for (int i = 0; i < 16; ++i) { const int c = 32 * kb + crow0(i); s[kb][i] = s[kb][i] * sc2 + stbl[t5_bucket(pq - sposb[c])]; }
    } else {
#pragma unroll
      for (int kb = 0; kb < 2; ++kb)
#pragma unroll
        for (int i = 0; i < 16; ++i) {
          const int c = 32 * kb + crow0(i);
          float v = s[kb][i] * sc2;
          if (HAS_T5) v += ((pq - sposb[c]) >= thr) ? tb1 : tb0;
          if (MODE == MODE_FOX) v += ((const float*)sposb)[c];
          s[kb][i] = v;
        }
    }
    if (!full) {
#pragma unroll
      for (int kb = 0; kb < 2; ++kb)
#pragma unroll
        for (int i = 0; i < 16; ++i) {
          const int c = 32 * kb + crow0(i);
          bool valid;
          if (MODE == MODE_CMP) valid = (16 * c <= rel);
          else valid = (c <= rel);
          if (MODE == MODE_WIN) valid = valid && (rel < 512 + c);
          if (MODE == MODE_SEL) valid = valid && mysel;
          s[kb][i] = valid ? s[kb][i] : NEGB;
        }
    }
  };
  const int tq0 = qs + wave * 32;
  auto tile_full = [&](int kt) __attribute__((always_inline)) -> bool {
    const int k0 = kt * 64;
    bool f;
    if (MODE == MODE_CMP) f = (16 * (k0 + 63) + 31 <= tq0);
    else f = (k0 + 63 <= tq0);
    if (MODE == MODE_WIN) f = f && (tq0 + 31 - k0 < 512);
    return __builtin_amdgcn_readfirstlane((int)f) != 0;
  };

  constexpr bool PF = false;
  constexpr bool REV = (MODE == MODE_FOX);
  int kt = REV ? kt_hi - 1 : kt_lo;
  if (MODE == MODE_SEL) kt = next_sel(sun, -1, kt_hi);
  if (PF && kt < kt_hi) issue(kt);
  while (REV ? (kt >= kt_lo) : (kt < kt_hi)) {
    __syncthreads();
    if (!PF) issue(kt);
    stash();
    __syncthreads();
    const int ktn = (MODE == MODE_SEL) ? next_sel(sun, kt, kt_hi) : (REV ? kt - 1 : kt + 1);
    if (PF && (REV ? (ktn >= kt_lo) : (ktn < kt_hi))) issue(ktn);
    bool mysel = true;
    if (MODE == MODE_SEL) mysel = (ssel[(kt >> 5) * 256 + tid] >> (kt & 31)) & 1;
    const unsigned long long selb = (MODE == MODE_SEL) ? __ballot(mysel) : ~0ull;
    if (selb != 0ull) {
      f32x16 s[2];
      const bool full = HAS_T5 ? false : tile_full(kt);
      logits(s, kt, mysel, full);
      float mx = NEGB;
#pragma unroll
      for (int kb = 0; kb < 2; ++kb)
#pragma unroll
        for (int i = 0; i < 16; ++i) mx = fmaxf(mx, s[kb][i]);
      mx = fmaxf(mx, shx32(mx));
      const float mn = fmaxf(m, mx);
      const float alpha = fexp2(m - mn);
      float ps = 0.f;
#pragma unroll
      for (int kb = 0; kb < 2; ++kb)
#pragma unroll
        for (int i = 0; i < 16; ++i) { const float v = s[kb][i]; const float e = (v > -1e29f) ? fexp2(v - mn) : 0.f; s[kb][i] = e; ps += e; }
      l = l * alpha + ps;
      if (__ballot(mn > m) != 0ull) {
#pragma unroll
        for (int db = 0; db < 4; ++db)
#pragma unroll
          for (int i = 0; i < 16; ++i) o[db][i] *= alpha;
      }
      m = mn;
      pv_tile(sV, s, o, r, h);
    }
    kt = ktn;
  }
  l += shx32(l);
  const float inv = l > 0.f ? 1.f / l : 0.f;
  if (MODE == MODE_WIN || MODE == MODE_CMP) {
    const float gw = ((const float*)(ws + O_GATES))[(size_t)tq * 24 + head * 3 + (MODE == MODE_WIN ? 2 : 0)] * inv;
    float* ow = (float*)(ws + (MODE == MODE_WIN ? O_OW : O_OC)) + opq(tq * 1024 + head * 128 + 4 * h);
#pragma unroll
    for (int db = 0; db < 4; ++db) {
#pragma unroll
      for (int q = 0; q < 4; ++q) *(float4*)(ow + 32 * db + 8 * q) = make_float4(o[db][4 * q] * gw, o[db][4 * q + 1] * gw, o[db][4 * q + 2] * gw, o[db][4 * q + 3] * gw);
    }
  } else if (MODE == MODE_SEL) {
    const float gs = ((const float*)(ws + O_GATES))[(size_t)tq * 24 + head * 3 + 1] * inv;
    const int ob_ = opq(tq * 1024 + head * 128 + 4 * h);
    const float* oc = (const float*)(ws + O_OC) + ob_;
    const float* ow = (const float*)(ws + O_OW) + ob_;
    u16* mix = (u16*)(ws + O_MIX) + opq(tq * D_ + head * 128 + 4 * h);
#pragma unroll
    for (int db = 0; db < 4; ++db) {
      float4 a[4], b[4];
#pragma unroll
      for (int q = 0; q < 4; ++q) { a[q] = *(const float4*)(oc + 32 * db + 8 * q); b[q] = *(const float4*)(ow + 32 * db + 8 * q); }
#pragma unroll
      for (int q = 0; q < 4; ++q)
        *(uint2*)(mix + 32 * db + 8 * q) = make_uint2(pack2(a[q].x + b[q].x + o[db][4 * q] * gs, a[q].y + b[q].y + o[db][4 * q + 1] * gs), pack2(a[q].z + b[q].z + o[db][4 * q + 2] * gs, a[q].w + b[q].w + o[db][4 * q + 3] * gs));
    }
  } else if (MODE == MODE_MLA) {
    u16* mix = (u16*)(ws + O_MIX) + opq(tq * D_ + 1024 + head * 128 + 4 * h);
#pragma unroll
    for (int db = 0; db < 4; ++db)
#pragma unroll
      for (int q = 0; q < 4; ++q)
        *(uint2*)(mix + 32 * db + 8 * q) = make_uint2(pack2(o[db][4 * q] * inv, o[db][4 * q + 1] * inv), pack2(o[db][4 * q + 2] * inv, o[db][4 * q + 3] * inv));
  } else {
    const int ob_ = opq(tq * D_ + head * 128 + 4 * h);
    const u16* og = (const u16*)(ws + O_OG) + ob_;
    u16* mix = (u16*)(ws + O_MIX) + ob_;
    uint2 gall[16];
#pragma unroll
    for (int j = 0; j < 16; ++j) gall[j] = *(const uint2*)(og + 8 * j);
#pragma unroll
    for (int db = 0; db < 4; ++db)
#pragma unroll
      for (int q = 0; q < 4; ++q) {
        const int dv = 32 * db + 8 * q;
        const uint2 gv = gall[4 * db + q];
        const float g0 = sigmoidf(__uint_as_float(gv.x << 16)), g1 = sigmoidf(__uint_as_float(gv.x & 0xffff0000u));
        const float g2 = sigmoidf(__uint_as_float(gv.y << 16)), g3 = sigmoidf(__uint_as_float(gv.y & 0xffff0000u));
        *(uint2*)(mix + dv) = make_uint2(pack2(o[db][4 * q] * inv * g0, o[db][4 * q + 1] * inv * g1), pack2(o[db][4 * q + 2] * inv * g2, o[db][4 * q + 3] * inv * g3));
      }
  }
  if (MODE == MODE_CMP) {
    float A[64];
#pragma unroll
    for (int i = 0; i < 64; ++i) A[i] = 0.f;
    for (int kt2 = 0; kt2 < kt_hi; ++kt2) {
      __syncthreads();
      issue(kt2, false);
      stash(false);
      __syncthreads();
      f32x16 s[2];
      logits(s, kt2, true, false);
      float loc[9];
#pragma unroll
      for (int i = 0; i < 9; ++i) loc[i] = 0.f;
#pragma unroll
      for (int kb = 0; kb < 2; ++kb)
#pragma unroll
        for (int q = 0; q < 4; ++q) {
          float e[4];
#pragma unroll
          for (int j = 0; j < 4; ++j) { const float v = s[kb][4 * q + j]; e[j] = (v > -1e29f) ? fexp2(v - m) * inv : 0.f; }
          const float g4 = (e[0] + e[1]) + (e[2] + e[3]);
          const float other = shx32(e[3]);
          loc[4 * kb + q] += g4 + (h ? other : 0.f);
          loc[4 * kb + q + 1] += (h ? 0.f : other);
        }
#pragma unroll
      for (int kk = 0; kk < 8; ++kk) {
        if (kk == kt2) {
#pragma unroll
          for (int j = 0; j < 8; ++j) A[8 * kk + j] += loc[j];
          if (8 * kk + 8 < 64) A[8 * kk + 8] += loc[8];
        }
      }
    }
    float* ib = (float*)(ws + O_IMP) + (((size_t)head * S_ + tq) * 2 + h) * 64;
#pragma unroll
    for (int j = 0; j < 16; ++j) *(float4*)(ib + 4 * j) = make_float4(A[4 * j], A[4 * j + 1], A[4 * j + 2], A[4 * j + 3]);
  }
}

DI void phase_attn_a(const Params& p, int bid, int nb, char* smem) {
  __shared__ uint4 s_item;
  unsigned* ctr = (unsigned*)(WS(p) + O_BAR);
  (void)bid; (void)nb;
  while (true) {
    __syncthreads();
    if (threadIdx.x == 0) s_item.x = atomicAdd(ctr, 1u);
    __syncthreads();
    const int it = __builtin_amdgcn_readfirstlane((int)s_item.x);
    if (it >= 1024) break;
    if (it < 512) attn_item<MODE_CMP>(p, 63 - (it >> 3), it & 7, smem);
    else { const int j = it - 512; attn_item<MODE_WIN>(p, 63 - (j >> 3), j & 7, smem); }
  }
}
DI void phase_topk(const Params& p, int bid, int nb) {
  for (int it = bid; it < 128; it += nb) topk_item(p, it >> 1, it & 1);
}
DI void phase_attn_b(const Params& p, int bid, int nb, char* smem) {
  const int xcd = bid & 7, slot = bid >> 3, per = nb >> 3;
  for (int s = slot; s < 64; s += per) {
#if !defined(DIAGQ) || DIAGQ == 1
    attn_item<MODE_MLA>(p, 63 - s, xcd, smem);
#endif
#if !defined(DIAGQ) || DIAGQ == 2
    attn_item<MODE_SEL>(p, s, xcd, smem);
#endif
  }
}
DI void phase_attn_fox(const Params& p, int bid, int nb, char* smem) {
  const int xcd = bid & 7, slot = bid >> 3, per = nb >> 3;
  for (int s = slot; s < 64; s += per) {
    attn_item<MODE_FOX>(p, 63 - s, 2 * xcd, smem);
    attn_item<MODE_FOX>(p, s, 2 * xcd + 1, smem);
  }
}

constexpr int NPHASE = 20;
constexpr int NPROG = 22;
__device__ __constant__ int c_prog[NPROG] = {0, 1, 2, 3, 4, 5, 6, 21, 7, 8, 9, 10, 11, 12, 13, 14, 15, 16, 17, 18, 19, 20};
DI void run_phase(const Params& p, int ph, int bid, int nb, char* smem) {
  char* ws = WS(p);
  const float* mod = (const float*)(ws + O_MOD);
  float* X1 = (float*)(ws + O_X1);
  switch (ph) {
    case 0: phase_prep(p, bid, nb, smem); break;
    case 1: phase_fin(p, bid, nb); break;
    case 2: phase_norm(p.x, p.norm_mix, mod + 2048, mod, (u16*)(ws + O_H), nullptr, bid, nb); break;
    case 3: phase_even_in(p, bid, nb, smem); break;
    case 4: phase_mla_up(p, bid, nb, smem); break;
    case 5: phase_cmp_out(p, bid, nb, smem); break;
    case 6: phase_attn_a(p, bid, nb, smem); break;
    case 7: phase_attn_b(p, bid, nb, smem); break;
    case 21: phase_topk(p, bid, nb); break;
    case 8: phase_resid(p, (const u16*)(ws + O_MIX), 2048, (const u16*)(ws + O_WOUT), p.x, mod + 4096, X1, bid, nb, smem); break;
    case 9: phase_norm(X1, p.norm_ffn, mod + 4 * 2048, mod + 3 * 2048, (u16*)(ws + O_H), nullptr, bid, nb); break;
    case 10: phase_ffn_up(p, (const u16*)(ws + O_W13_0), bid, nb, smem); break;
    case 11: phase_resid(p, (const u16*)(ws + O_U), F_, (const u16*)(ws + O_W2_0), X1, mod + 5 * 2048, X1, bid, nb, smem); break;
    case 12: phase_norm(X1, p.norm_mix + 2048, mod + 12288 + 2048, mod + 12288, (u16*)(ws + O_H), nullptr, bid, nb); break;
    case 13: phase_fox_in(p, bid, nb, smem); break;
    case 14: phase_cumsum(p, bid, nb, smem); break;
    case 15: phase_attn_fox(p, bid, nb, smem); break;
    case 16: phase_resid(p, (const u16*)(ws + O_MIX), 2048, (const u16*)(ws + O_WFOUT), X1, mod + 12288 + 4096, X1, bid, nb, smem); break;
    case 17: phase_norm(X1, p.norm_ffn + 2048, mod + 12288 + 4 * 2048, mod + 12288 + 3 * 2048, (u16*)(ws + O_H), nullptr, bid, nb); break;
    case 18: phase_ffn_up(p, (const u16*)(ws + O_W13_1), bid, nb, smem); break;
    case 19: phase_resid(p, (const u16*)(ws + O_U), F_, (const u16*)(ws + O_W2_1), X1, mod + 12288 + 5 * 2048, X1, bid, nb, smem); break;
    default: phase_norm(X1, p.final_norm, nullptr, nullptr, nullptr, p.out, bid, nb); break;
  }
}


#define XB_TMO      128
#define XB_XCNT(j)  (256  + 64 * (j))
#define XB_XSUB(j)  (1280 + 64 * (j))
#define XB_XGEN(j)  (2304 + 64 * (j))
#define XB_TOP      3328
#define XB_TOPGEN   3392
#define XCD_BAR_WORDS 3456
#define XB_SPIN_CAP (1u << 18)
#define LAS __attribute__((address_space(3)))
DI unsigned xb_ld(unsigned* p)              { return __hip_atomic_load(p, __ATOMIC_RELAXED, __HIP_MEMORY_SCOPE_AGENT); }
DI unsigned xb_add(unsigned* p, unsigned v) { return __hip_atomic_fetch_add(p, v, __ATOMIC_RELAXED, __HIP_MEMORY_SCOPE_AGENT); }
DI unsigned xb_xcc_id() { return (unsigned)__builtin_amdgcn_s_getreg((3 << 11) | 20) & 0xFu; }
#define XB_SPIN(cond, bar) do { while (cond) { } } while (0)
struct XcdBarrier { unsigned* bar; unsigned x; volatile LAS unsigned* st; };
DI XcdBarrier xcd_barrier_post(unsigned* bar, volatile LAS unsigned* st) {
  XcdBarrier b; b.bar = bar; b.x = xb_xcc_id(); b.st = st;
  if (threadIdx.x == 0) st[2] = xb_add(&bar[XB_XCNT(b.x)], 1u);
  return b;
}
DI void xcd_barrier_complete(unsigned* bar, unsigned x, unsigned& nloc, unsigned& nx) {
  const unsigned G = gridDim.x * gridDim.y * gridDim.z;
  unsigned sum, cnt, mine;
  for (;;) {
    sum = 0u; cnt = 0u; mine = 0u;
#pragma unroll
    for (unsigned j = 0; j < 16; ++j) { const unsigned c = xb_ld(&bar[XB_XCNT(j)]); sum += c; cnt += (c > 0u) ? 1u : 0u; mine = (j == x) ? c : mine; }
    if (sum == G) break;
    __builtin_amdgcn_s_sleep(1);
  }
  nloc = mine > 0u ? mine : 1u; nx = cnt > 0u ? cnt : 1u;
}
DI void xcd_barrier(const XcdBarrier& b) {
  asm volatile("s_waitcnt vmcnt(0)" ::: "memory");
  __syncthreads();
  if (threadIdx.x == 0) {
    unsigned* bar = b.bar;
    __builtin_amdgcn_s_waitcnt(0);
    unsigned nloc = b.st[0], nx = b.st[1];
    if (nloc == 0u) { xcd_barrier_complete(bar, b.x, nloc, nx); b.st[0] = nloc; b.st[1] = nx; }
    const unsigned old = xb_add(&bar[XB_XSUB(b.x)], 1u);
    const unsigned gen = old / nloc;
    if (old + 1u == (gen + 1u) * nloc) {
      __builtin_amdgcn_fence(__ATOMIC_RELEASE, "agent");
      asm volatile("s_waitcnt vmcnt(0)" ::: "memory");
      const unsigned og = xb_add(&bar[XB_TOP], 1u);
      const unsigned tg = og / nx;
      if (og + 1u == (tg + 1u) * nx) xb_add(&bar[XB_TOPGEN], 1u);
      else XB_SPIN(xb_ld(&bar[XB_TOPGEN]) == tg, bar);
      __builtin_amdgcn_fence(__ATOMIC_ACQUIRE, "agent");
      xb_add(&bar[XB_XGEN(b.x)], 1u);
      asm volatile("s_waitcnt vmcnt(0)" ::: "memory");
    } else {
      XB_SPIN(xb_ld(&bar[XB_XGEN(b.x)]) == gen, bar);
      __builtin_amdgcn_fence(__ATOMIC_ACQUIRE, "agent");
      asm volatile("s_waitcnt vmcnt(0)" ::: "memory");
    }
  }
  __syncthreads();
}

#if MULTI
template <int PH> __global__ void __launch_bounds__(256, 2) phase_kernel(Params p) {
  __shared__ __attribute__((aligned(16))) char smem[SMEM_BYTES];
  run_phase(p, PH, blockIdx.x, gridDim.x, smem);
}
template <int PH> void launch_all(const Params& p, hipStream_t stream) {
  hipLaunchKernelGGL(phase_kernel<PH>, dim3(512), dim3(256), 0, stream, p);
  if constexpr (PH < NPHASE + 1) launch_all<PH + 1>(p, stream);
}
#else
__global__ void __launch_bounds__(256, 2) fwd_megakernel(Params p) {
  __shared__ __attribute__((aligned(16))) char smem[SMEM_BYTES];
  cg::grid_group grid = cg::this_grid();
  const int bid = blockIdx.x, nb = gridDim.x;
  __shared__ uint4 xb_words;
  unsigned* bar = (unsigned*)(WS(p) + O_BAR);
  if (threadIdx.x == 0) xb_words = make_uint4(0u, 0u, 0u, 0u);
  __syncthreads();
  XcdBarrier xb = xcd_barrier_post(bar, (volatile LAS unsigned*)&xb_words);
  if (nb == 12345) grid.sync();
  run_phase(p, c_prog[0], bid, nb, smem);
  xcd_barrier(xb);
  int vbid = bid;
  {
    bool even = true;
    for (int j = 0; j < 8; ++j) even = even && (xb_ld(&bar[XB_XCNT(j)]) == (unsigned)(nb >> 3));
    const int rank = (int)((volatile LAS unsigned*)&xb_words)[2];
    if (even && (nb & 7) == 0) vbid = rank * 8 + (int)xb.x;
  }
  vbid = __builtin_amdgcn_readfirstlane(vbid);
  for (int i = 1; i < NPROG; ++i) {
    const int ph = c_prog[i];
    run_phase(p, ph, vbid, nb, smem);
#ifdef PROBE_DUP
    if (ph == PROBE_DUP) { xcd_barrier(xb); run_phase(p, ph, vbid, nb, smem); }
#endif
    if (i + 1 < NPROG) xcd_barrier(xb);
  }
}
#endif

extern "C" void kernel_launch(void* const* d_in, const int* in_sizes, int n_in, void* d_out, int out_size, void* d_ws, size_t ws_size, hipStream_t stream) {
  Params p{};
  p.x = (const float*)d_in[0]; p.c = (const float*)d_in[1]; p.pos = (const int*)d_in[2];
  p.rel_bias = (const float*)d_in[3]; p.ada_w = (const float*)d_in[4]; p.ada_b = (const float*)d_in[5];
  p.norm_mix = (const float*)d_in[6]; p.norm_ffn = (const float*)d_in[7];
  p.ffn_w1 = (const float*)d_in[8]; p.ffn_w3 = (const float*)d_in[9]; p.ffn_w2 = (const float*)d_in[10];
  p.even_w_in = (const float*)d_in[11]; p.even_w_out = (const float*)d_in[12]; p.gate_b = (const float*)d_in[13];
  p.cmp_pos_k = (const float*)d_in[14]; p.cmp_w1_k = (const float*)d_in[15]; p.cmp_w2_k = (const float*)d_in[16];
  p.cmp_pos_v = (const float*)d_in[17]; p.cmp_w1_v = (const float*)d_in[18]; p.cmp_w2_v = (const float*)d_in[19];
  p.mla_q_norm = (const float*)d_in[20]; p.mla_w_uq = (const float*)d_in[21]; p.mla_kv_norm = (const float*)d_in[22]; p.mla_w_ukv = (const float*)d_in[23];
  p.fox_w_in = (const float*)d_in[24]; p.fox_w_out = (const float*)d_in[25]; p.fox_f_b = (const float*)d_in[26];
  p.fox_q_norm = (const float*)d_in[27]; p.fox_k_norm = (const float*)d_in[28]; p.final_norm = (const float*)d_in[29];
  p.out = (float*)d_out; p.ws = (char*)d_ws;
  for (int j = 0; j < NJOBS; ++j) p.jobs[j] = get_job(p, j);
  for (int j = 0; j < 32; ++j) p.inv_freq[j] = (float)pow(10000.0, -(double)j / 32.0);
  for (int b = 0; b < 32; ++b) p.t5thr[b] = b < 16 ? b : (int)ceil(16.0 * pow(2.0, (b - 16) * 0.5));
  if (ws_size < WS_NEED) { fprintf(stderr, "workspace too small: %zu < %zu\n", ws_size, (size_t)WS_NEED); return; }
#if MULTI
  launch_all<0>(p, stream);
#else
  static int grid_blocks = 0;
  if (!grid_blocks) {
    int dev = 0, cus = 0, per_cu = 0;
    (void)hipGetDevice(&dev);
    (void)hipDeviceGetAttribute(&cus, hipDeviceAttributeMultiprocessorCount, dev);
    (void)hipOccupancyMaxActiveBlocksPerMultiprocessor(&per_cu, fwd_megakernel, 256, 0);
    if (per_cu > 2) per_cu = 2;
    grid_blocks = cus * per_cu;
  }
  (void)hipMemsetAsync((char*)d_ws + O_BAR, 0, XCD_BAR_WORDS * sizeof(unsigned), stream);
  void* args[] = {&p};
  hipError_t e = hipLaunchCooperativeKernel((void*)fwd_megakernel, dim3(grid_blocks), dim3(256), args, 0, stream);
  if (e != hipSuccess) fprintf(stderr, "cooperative launch failed: %s (grid %d)\n", hipGetErrorString(e), grid_blocks);
#endif
}
```

```cpp
#include <hip/hip_runtime.h>
#include <hip/hip_cooperative_groups.h>
#include <cstdio>
#include <cmath>
namespace cg = cooperative_groups;

typedef unsigned short u16;
typedef unsigned int u32;
using bf16x8 = __attribute__((ext_vector_type(8))) short;
using s16x4 = __attribute__((ext_vector_type(4))) short;
using f32x16 = __attribute__((ext_vector_type(16))) float;
using u32x4 = __attribute__((ext_vector_type(4))) unsigned int;
using f32x4 = __attribute__((ext_vector_type(4))) float;
using u32x2 = __attribute__((ext_vector_type(2))) unsigned int;
#define DI __device__ __forceinline__
#define SB0 __builtin_amdgcn_sched_barrier(0)
#define MFMA32(a, b, c) __builtin_amdgcn_mfma_f32_32x32x16_bf16((a), (b), (c), 0, 0, 0)

#ifndef MULTI
#define MULTI 0
#endif

constexpr int S_ = 8192, D_ = 2048, F_ = 5632;
constexpr int NIN0 = 3712;
constexpr int NIN1 = 8320;
constexpr float LOG2E = 1.4426950408889634f;
constexpr float NEGB = -1e30f;

constexpr size_t AL(size_t x) { return (x + 255) & ~(size_t)255; }
constexpr size_t O_WIN = 0;
constexpr size_t O_WOUT = O_WIN + AL((size_t)NIN0 * 2048 * 2);
constexpr size_t O_W1K = O_WOUT + AL((size_t)2048 * 2048 * 2);
constexpr size_t O_W1V = O_W1K + AL((size_t)256 * 4096 * 2);
constexpr size_t O_W2K = O_W1V + AL((size_t)256 * 4096 * 2);
constexpr size_t O_W2V = O_W2K + AL((size_t)128 * 256 * 2);
constexpr size_t O_WUQ = O_W2V + AL((size_t)128 * 256 * 2);
constexpr size_t O_WUKV = O_WUQ + AL((size_t)1536 * 512 * 2);
constexpr size_t O_WFIN = O_WUKV + AL((size_t)2048 * 512 * 2);
constexpr size_t O_WFOUT = O_WFIN + AL((size_t)NIN1 * 2048 * 2);
constexpr size_t O_W13_0 = O_WFOUT + AL((size_t)2048 * 2048 * 2);
constexpr size_t O_W13_1 = O_W13_0 + AL((size_t)2 * F_ * 2048 * 2);
constexpr size_t O_W2_0 = O_W13_1 + AL((size_t)2 * F_ * 2048 * 2);
constexpr size_t O_W2_1 = O_W2_0 + AL((size_t)2048 * F_ * 2);
constexpr size_t O_MODP = O_W2_1 + AL((size_t)2048 * F_ * 2);
constexpr size_t O_MOD = O_MODP + AL((size_t)16 * 24576 * 4);
constexpr size_t O_C1P = O_MOD + AL((size_t)24576 * 4);
constexpr size_t O_C1 = O_C1P + AL((size_t)2 * 64 * 256 * 4);
constexpr size_t O_ROPE = O_C1 + AL((size_t)2 * 256 * 4);
constexpr size_t O_H = O_ROPE + AL((size_t)S_ * 32 * 8);
constexpr size_t O_X1 = O_H + AL((size_t)S_ * D_ * 2);
constexpr size_t O_U = O_X1 + AL((size_t)S_ * D_ * 4);
constexpr size_t O_MIX = O_U + AL((size_t)S_ * F_ * 2);
constexpr size_t O_L = O_MIX + AL((size_t)S_ * D_ * 2);
constexpr size_t O_QN = O_L;
constexpr size_t O_KCS = O_QN + AL((size_t)8 * S_ * 128 * 2);
constexpr size_t O_VCS = O_KCS + AL((size_t)2 * S_ * 128 * 2 + 8192);
constexpr size_t O_KS = O_VCS + AL((size_t)2 * S_ * 128 * 2 + 8192);
constexpr size_t O_VST = O_KS + AL((size_t)2 * S_ * 128 * 2);
constexpr size_t O_KW = O_VST + AL((size_t)2 * S_ * 128 * 2);
constexpr size_t O_VWT = O_KW + AL((size_t)2 * S_ * 128 * 2);
constexpr size_t O_CQ = O_VWT + AL((size_t)2 * S_ * 128 * 2);
constexpr size_t O_CKV = O_CQ + AL((size_t)S_ * 512 * 2);
constexpr size_t O_GATES = O_CKV + AL((size_t)S_ * 512 * 2);
constexpr size_t O_QM = O_GATES + AL((size_t)S_ * 24 * 4);
constexpr size_t O_KM = O_QM + AL((size_t)8 * S_ * 192 * 2);
constexpr size_t O_VMT = O_KM + AL((size_t)8 * S_ * 192 * 2);
constexpr size_t O_HC = O_VMT + AL((size_t)8 * S_ * 128 * 2);
constexpr size_t O_KC = O_HC + AL((size_t)4 * 512 * 256 * 2);
constexpr size_t O_VCT = O_KC + AL((size_t)2 * 512 * 128 * 2);
constexpr size_t O_OC = O_VCT + AL((size_t)2 * 512 * 128 * 2);
constexpr size_t O_OW = O_OC + AL((size_t)S_ * 1024 * 4);
constexpr size_t O_IMP = O_OW + AL((size_t)S_ * 1024 * 4);
constexpr size_t O_SELM = O_IMP + AL((size_t)8 * S_ * 128 * 4);
constexpr size_t O_KRAW = O_SELM + AL((size_t)2 * S_ * 16);
constexpr size_t O_HCP = O_KRAW + AL((size_t)S_ * 88 * 4);
constexpr size_t O_L0END = O_HCP + AL((size_t)4 * 4 * 512 * 256 * 4);
constexpr size_t O_QF = O_L;
constexpr size_t O_KF = O_QF + AL((size_t)16 * S_ * 128 * 2);
constexpr size_t O_VFT = O_KF + AL((size_t)16 * S_ * 128 * 2);
constexpr size_t O_OG = O_VFT + AL((size_t)16 * S_ * 128 * 2);
constexpr size_t O_FL = O_OG + AL((size_t)S_ * D_ * 2);
constexpr size_t O_CUM = O_FL + AL((size_t)4 * S_ * 16 * 4);
constexpr size_t O_L1END = O_CUM + AL((size_t)S_ * 16 * 4);
constexpr size_t O_BAR = (O_L0END > O_L1END ? O_L0END : O_L1END);
constexpr size_t WS_NEED = O_BAR + 16384;

struct ConvJob { const float* src; const float* src2; const float* scale; u16* dst; int ld; int K; int Nd; int map; };
constexpr int NJOBS = 14;
struct Params {
  const float *x, *c; const int* pos;
  const float *rel_bias, *ada_w, *ada_b, *norm_mix, *norm_ffn, *ffn_w1, *ffn_w3, *ffn_w2, *even_w_in, *even_w_out, *gate_b,
      *cmp_pos_k, *cmp_w1_k, *cmp_w2_k, *cmp_pos_v, *cmp_w1_v, *cmp_w2_v, *mla_q_norm, *mla_w_uq, *mla_kv_norm, *mla_w_ukv,
      *fox_w_in, *fox_w_out, *fox_f_b, *fox_q_norm, *fox_k_norm, *final_norm;
  float* out;
  char* ws;
  ConvJob jobs[NJOBS];
  float inv_freq[32];
  int t5thr[32];
};

constexpr int SMEM_BYTES = 63488;

DI u16 f2bf(float f) { __bf16 b = (__bf16)f; return __builtin_bit_cast(u16, b); }
DI float bf2f(u16 v) { return __uint_as_float(((u32)v) << 16); }
DI u32 pack2(float a, float b) { return (u32)f2bf(a) | ((u32)f2bf(b) << 16); }
DI int opq(int v) { asm volatile("" : "+v"(v)); return v; }
#define GAS __attribute__((address_space(1)))
template <class T> DI T* GP(T* q) { return (T*)(GAS T*)q; }
DI char* WS(const Params& p) { GAS char* w = (GAS char*)p.ws; asm volatile("" : "+s"(w)); return (char*)w; }
DI int otid() { int v = (int)threadIdx.x; asm volatile("" : "+v"(v)); return v; }
DI int crow0(int i) { return (i & 3) + 8 * (i >> 2); }
DI int crow(int i, int h) { return (i & 3) + 8 * (i >> 2) + 4 * h; }
DI float siluf(float v) { return v / (1.f + __expf(-v)); }
DI float sigmoidf(float v) { return 1.f / (1.f + __expf(-v)); }
DI float fexp2(float v) { return __builtin_amdgcn_exp2f(v); }
DI float shx32(float v) { return __shfl_xor(v, 32, 64); }
DI int t5_bucket(int d) {
  d = d < 0 ? 0 : d;
  const int dd = d > 4096 ? 4096 : d;
  const int e = 31 - __clz(dd | 1);
  int big = 8 + 2 * e + ((dd * dd) >> (2 * e + 1));
  big = big > 31 ? 31 : big;
  return d < 16 ? d : big;
}
DI bf16x8 pack8(const f32x16& x, int s) {
  u32 a = pack2(x[8 * s], x[8 * s + 1]), b = pack2(x[8 * s + 2], x[8 * s + 3]), c = pack2(x[8 * s + 4], x[8 * s + 5]), d = pack2(x[8 * s + 6], x[8 * s + 7]);
  uint4 v = make_uint4(a, b, c, d);
  return __builtin_bit_cast(bf16x8, v);
}

__device__ __constant__ int c_job_tiles[NJOBS] = {16 * 29, 16 * 16, 32 * 2, 32 * 2, 2 * 1, 2 * 1, 4 * 12, 4 * 16, 16 * 65, 16 * 16, 16 * 88, 16 * 88, 44 * 16, 44 * 16};
constexpr int CONV_TILES = 16 * 29 + 16 * 16 + 32 * 2 * 2 + 2 * 2 + 4 * 12 + 4 * 16 + 16 * 65 + 16 * 16 + 2 * 16 * 88 + 2 * 44 * 16;

static ConvJob get_job(const Params& p, int j) {
  ConvJob J; J.src2 = nullptr; J.scale = nullptr; J.map = 0;
  char* ws = p.ws;
  switch (j) {
    case 0: J.src = p.even_w_in; J.dst = (u16*)(ws + O_WIN); J.ld = 3672; J.K = 2048; J.Nd = NIN0; J.map = 1; break;
    case 1: J.src = p.even_w_out; J.dst = (u16*)(ws + O_WOUT); J.ld = 2048; J.K = 2048; J.Nd = 2048; break;
    case 2: J.src = p.cmp_w1_k; J.dst = (u16*)(ws + O_W1K); J.ld = 256; J.K = 4096; J.Nd = 256; break;
    case 3: J.src = p.cmp_w1_v; J.dst = (u16*)(ws + O_W1V); J.ld = 256; J.K = 4096; J.Nd = 256; break;
    case 4: J.src = p.cmp_w2_k; J.dst = (u16*)(ws + O_W2K); J.ld = 128; J.K = 256; J.Nd = 128; break;
    case 5: J.src = p.cmp_w2_v; J.dst = (u16*)(ws + O_W2V); J.ld = 128; J.K = 256; J.Nd = 128; break;
    case 6: J.src = p.mla_w_uq; J.dst = (u16*)(ws + O_WUQ); J.ld = 1536; J.K = 512; J.Nd = 1536; J.map = 2; J.scale = p.mla_q_norm; break;
    case 7: J.src = p.mla_w_ukv; J.dst = (u16*)(ws + O_WUKV); J.ld = 2048; J.K = 512; J.Nd = 2048; J.scale = p.mla_kv_norm; break;
    case 8: J.src = p.fox_w_in; J.dst = (u16*)(ws + O_WFIN); J.ld = 8208; J.K = 2048; J.Nd = NIN1; J.map = 3; break;
    case 9: J.src = p.fox_w_out; J.dst = (u16*)(ws + O_WFOUT); J.ld = 2048; J.K = 2048; J.Nd = 2048; break;
    case 10: J.src = p.ffn_w1; J.src2 = p.ffn_w3; J.dst = (u16*)(ws + O_W13_0); J.ld = F_; J.K = 2048; J.Nd = 2 * F_; J.map = 4; break;
    case 11: J.src = p.ffn_w1 + (size_t)2048 * F_; J.src2 = p.ffn_w3 + (size_t)2048 * F_; J.dst = (u16*)(ws + O_W13_1); J.ld = F_; J.K = 2048; J.Nd = 2 * F_; J.map = 4; break;
    case 12: J.src = p.ffn_w2; J.dst = (u16*)(ws + O_W2_0); J.ld = 2048; J.K = F_; J.Nd = 2048; break;
    default: J.src = p.ffn_w2 + (size_t)F_ * 2048; J.dst = (u16*)(ws + O_W2_1); J.ld = 2048; J.K = F_; J.Nd = 2048; break;
  }
  return J;
}

DI int map_col(int map, int n, int& which) {
  which = 0;
  switch (map) {
    case 0: return n;
    case 1: if (n < 2560) return n; if (n < 3648) return n + 24; if (n < 3672) return n - 3648 + 2560; return -1;
    case 2: if (n < 1024) return (n >> 7) * 192 + (n & 127); { int m = n - 1024; return (m >> 6) * 192 + 128 + (m & 63); }
    case 3: if (n < 6144) return n; if (n < 8192) return n + 16; if (n < 8208) return n - 8192 + 6144; return -1;
    default: { int w = n & 63; which = w >> 5; return (n >> 6) * 32 + (w & 31); }
  }
}

DI void conv_tile(const ConvJob& J, int tile, char* smem) {
  u32* st = (u32*)smem;
  const int tid = otid();
  const int ntn = J.Nd >> 7;
  const int kt = tile / ntn, nt = tile - kt * ntn;
  const int k0 = kt * 128, n0 = nt * 128;
  {
    const int n4 = tid & 31, kp = tid >> 5;
    int which; const int sc = map_col(J.map, n0 + 4 * n4, which);
    const float* src = (which ? J.src2 : J.src) + (size_t)(k0 + 2 * kp) * J.ld + (sc >= 0 ? sc : 0);
    float4 va[8], vb[8];
#pragma unroll
    for (int i = 0; i < 8; ++i) {
      if (sc >= 0) {
        const f32x4 a_ = __builtin_nontemporal_load((const f32x4*)(src + (size_t)(16 * i) * J.ld)), b_ = __builtin_nontemporal_load((const f32x4*)(src + (size_t)(16 * i + 1) * J.ld));
        va[i] = make_float4(a_.x, a_.y, a_.z, a_.w); vb[i] = make_float4(b_.x, b_.y, b_.z, b_.w);
      }
      else { va[i] = make_float4(0, 0, 0, 0); vb[i] = va[i]; }
    }
#pragma unroll
    for (int i = 0; i < 8; ++i) {
      float sa = 1.f, sb = 1.f;
      if (J.scale) { sa = J.scale[k0 + 16 * i + 2 * kp]; sb = J.scale[k0 + 16 * i + 2 * kp + 1]; }
      u32x4 w = {pack2(va[i].x * sa, vb[i].x * sb), pack2(va[i].y * sa, vb[i].y * sb), pack2(va[i].z * sa, vb[i].z * sb), pack2(va[i].w * sa, vb[i].w * sb)};
      *(u32x4*)(st + (8 * i + kp) * 132 + 4 * n4) = w;
    }
  }
  __syncthreads();
  {
    const int nr = tid & 127, kh = tid >> 7;
    const u32* sp = st + (32 * kh) * 132 + nr;
    u32x4* d = (u32x4*)(J.dst + (size_t)(n0 + nr) * J.K + k0 + 64 * kh);
#pragma unroll
    for (int j = 0; j < 8; ++j) {
      u32x4 w = {sp[(4 * j) * 132], sp[(4 * j + 1) * 132], sp[(4 * j + 2) * 132], sp[(4 * j + 3) * 132]};
      d[j] = w;
    }
  }
  __syncthreads();
}

DI void phase_prep(const Params& p, int bid, int nb, char* smem) {
  const int tid = otid();
  constexpr int N_ADA = 2 * 12 * 16, N_C1 = 2 * 64;
  const int total = N_ADA + N_C1 + CONV_TILES;
  __shared__ uint4 s_item;
  unsigned* ctr = (unsigned*)(WS(p) + O_BAR) + 9;
  (void)bid; (void)nb;
  while (true) {
    __syncthreads();
    if (threadIdx.x == 0) s_item.x = atomicAdd(ctr, 1u);
    __syncthreads();
    const int it = __builtin_amdgcn_readfirstlane((int)s_item.x);
    if (it >= total) break;
    if (it < N_ADA) {
      const int layer = it / 192, rem = it % 192, cc = rem / 16, kc = rem % 16;
      const float* w = p.ada_w + (size_t)layer * 2048 * 12288 + (size_t)(kc * 128) * 12288 + cc * 1024 + tid * 4;
      float4 acc = make_float4(0, 0, 0, 0);
#pragma unroll 8
      for (int k = 0; k < 128; ++k) {
        const float cv = siluf(p.c[kc * 128 + k]);
        const f32x4 wv = __builtin_nontemporal_load((const f32x4*)(w + (size_t)k * 12288));
        acc.x += cv * wv.x; acc.y += cv * wv.y; acc.z += cv * wv.z; acc.w += cv * wv.w;
      }
      float* mp = (float*)(WS(p) + O_MODP) + (size_t)kc * 24576 + layer * 12288 + cc * 1024 + tid * 4;
      *(float4*)mp = acc;
    } else if (it < N_ADA + N_C1) {
      const int j = it - N_ADA, which = j >> 6, kc = j & 63;
      const float* w = (which ? p.cmp_w1_v : p.cmp_w1_k) + (size_t)(kc * 64) * 256 + tid;
      const float* pe = (which ? p.cmp_pos_v : p.cmp_pos_k) + kc * 64;
      float acc = 0.f;
#pragma unroll 8
      for (int k = 0; k < 64; ++k) acc += pe[k] * __builtin_nontemporal_load(w + (size_t)k * 256);
      ((float*)(WS(p) + O_C1P))[(which * 64 + kc) * 256 + tid] = acc;
    } else {
      int t = it - N_ADA - N_C1, j = 0;
      while (t >= c_job_tiles[j]) { t -= c_job_tiles[j]; ++j; }
      conv_tile(p.jobs[j], t, smem);
    }
  }
}

DI void sincos_r(float x, float& s, float& c) {
  const float n = rintf(x * 0.15915494309189535f);
  float r = fmaf(-n, 6.28125f, x);
  r = fmaf(-n, 1.9353071795864769e-3f, r);
  s = __sinf(r); c = __cosf(r);
}

DI void phase_fin(const Params& p, int bid, int nb) {
  const int gt = bid * 256 + otid(), nt = nb * 256;
  const float* mp = (const float*)(WS(p) + O_MODP);
  float* mod = (float*)(WS(p) + O_MOD);
  for (int i = gt; i < 24576; i += nt) {
    float a = p.ada_b[i];
    for (int k = 0; k < 16; ++k) a += mp[(size_t)k * 24576 + i];
    mod[i] = a;
  }
  const float* cp = (const float*)(WS(p) + O_C1P);
  float* c1 = (float*)(WS(p) + O_C1);
  for (int i = gt; i < 512; i += nt) {
    const int which = i >> 8, j = i & 255;
    float a = 0.f;
    for (int k = 0; k < 64; ++k) a += cp[(which * 64 + k) * 256 + j];
    c1[i] = a;
  }
  float2* rt = (float2*)(WS(p) + O_ROPE);
  for (int i = gt; i < S_ * 32; i += nt) {
    const int t = i >> 5, j = i & 31;
    const float ang = (float)p.pos[t] * p.inv_freq[j];
    float s, c; sincos_r(ang, s, c);
    rt[i] = make_float2(c, s);
  }
}

DI void phase_norm(const float* xin, const float* g, const float* sc, const float* sh, u16* dstb, float* dstf, int bid, int nb) {
  const int lane = otid() & 63;
  const int gw = bid * 4 + (otid() >> 6), nw = nb * 4;
  for (int row = gw; row < S_; row += nw) {
    const float4* xr = (const float4*)(xin + (size_t)row * D_);
    float4 v[8]; float ss = 0.f;
#pragma unroll
    for (int i = 0; i < 8; ++i) { v[i] = xr[lane + 64 * i]; ss += v[i].x * v[i].x + v[i].y * v[i].y + v[i].z * v[i].z + v[i].w * v[i].w; }
#pragma unroll
    for (int o = 32; o >= 1; o >>= 1) ss += __shfl_xor(ss, o, 64);
    const float rstd = rsqrtf(ss * (1.f / D_) + 1e-6f);
#pragma unroll
    for (int i = 0; i < 8; ++i) {
      const int c0 = (lane + 64 * i) * 4;
      const float4 gv = *(const float4*)(g + c0);
      float4 y = make_float4(v[i].x * rstd * gv.x, v[i].y * rstd * gv.y, v[i].z * rstd * gv.z, v[i].w * rstd * gv.w);
      if (dstb) {
        const float4 a = *(const float4*)(sc + c0), b = *(const float4*)(sh + c0);
        y.x = y.x * (1.f + a.x) + b.x; y.y = y.y * (1.f + a.y) + b.y; y.z = y.z * (1.f + a.z) + b.z; y.w = y.w * (1.f + a.w) + b.w;
        *(uint2*)(dstb + (size_t)row * D_ + c0) = make_uint2(pack2(y.x, y.y), pack2(y.z, y.w));
      } else {
        *(float4*)(dstf + (size_t)row * D_ + c0) = y;
      }
    }
  }
}

constexpr int MB = 4, WMS = 32 * MB, BM = 2 * WMS;
constexpr int GST = 72;
constexpr int GEMM_LDS = (BM + 128) * GST * 2;
struct GemmIn { const u16* A; long lda; int mclamp; const u16* Bt; long ldb; int K; };

DI void gemm_tile(const GemmIn& g, int m0, int n0, char* smem, f32x16 (&acc)[MB][2]) {
  u16* sA = (u16*)smem; u16* sB = sA + BM * GST;
  const int tid = otid(), wave = tid >> 6, lane = tid & 63, r = lane & 31, h = lane >> 5, wm = wave >> 1, wn = wave & 1;
#pragma unroll
  for (int a = 0; a < MB; ++a)
#pragma unroll
    for (int b = 0; b < 2; ++b)
#pragma unroll
      for (int i = 0; i < 16; ++i) acc[a][b][i] = 0.f;
  const int lrow = tid >> 3, lkc = (tid & 7) * 8;
  const unsigned ago = (unsigned)opq((m0 + lrow) * (int)g.lda + lkc), bgo = (unsigned)opq((n0 + lrow) * (int)g.ldb + lkc);
  const int lo = opq(lrow * GST + lkc);
  u32x4 ra[8], rb[4];
  const int nk = g.K >> 6;
#pragma unroll
  for (int i = 0; i < 8; ++i) ra[i] = *(const u32x4*)(g.A + (size_t)(32 * i) * g.lda + ago);
#pragma unroll
  for (int i = 0; i < 4; ++i) rb[i] = *(const u32x4*)(g.Bt + (size_t)(32 * i) * g.ldb + bgo);
  const int aoff = opq((WMS * wm + r) * GST + 8 * h), boff = opq((64 * wn + r) * GST + 8 * h);
  for (int kt = 0; kt < nk; ++kt) {
    __syncthreads();
#pragma unroll
    for (int i = 0; i < 8; ++i) *(u32x4*)(sA + lo + 32 * i * GST) = ra[i];
#pragma unroll
    for (int i = 0; i < 4; ++i) *(u32x4*)(sB + lo + 32 * i * GST) = rb[i];
    __syncthreads();
    if (kt + 1 < nk) {
#pragma unroll
      for (int i = 0; i < 8; ++i) ra[i] = *(const u32x4*)(g.A + ((size_t)(32 * i) * g.lda + (kt + 1) * 64) + ago);
#pragma unroll
      for (int i = 0; i < 4; ++i) rb[i] = *(const u32x4*)(g.Bt + ((size_t)(32 * i) * g.ldb + (kt + 1) * 64) + bgo);
    }
#pragma unroll
    for (int ks = 0; ks < 4; ++ks) {
      bf16x8 af[MB], bf[2];
#pragma unroll
      for (int mb = 0; mb < MB; ++mb) af[mb] = *(const bf16x8*)(sA + aoff + 32 * mb * GST + 16 * ks);
#pragma unroll
      for (int nb2 = 0; nb2 < 2; ++nb2) bf[nb2] = *(const bf16x8*)(sB + boff + 32 * nb2 * GST + 16 * ks);
#pragma unroll
      for (int mb = 0; mb < MB; ++mb)
#pragma unroll
        for (int nb2 = 0; nb2 < 2; ++nb2) acc[mb][nb2] = MFMA32(af[mb], bf[nb2], acc[mb][nb2]);
    }
  }
  __syncthreads();
}

DI bool tile_coord(int it, int bid, int nb, int MT, int NT, int& mt, int& nt) {
  const int per = nb >> 3;
  const int idx = (it * 8 + (bid & 7)) * per + (bid >> 3);
  if (idx >= MT * NT) return false;
  const int pfull = 8 * MT;
  const int pnl = idx / pfull;
  const int rem = idx - pnl * pfull;
  const int left = NT - pnl * 8;
  if (left >= 8) { mt = rem >> 3; nt = pnl * 8 + (rem & 7); }
  else { mt = rem / left; nt = pnl * 8 + rem % left; }
  return true;
}

DI void store_bf16(const f32x16 (&acc)[MB][2], u16* dst, int ld, int wm, int wn, int r, int h, float rs_mul = 1.f) {
  u16* b = dst + opq((WMS * wm + 4 * h) * ld + 64 * wn + r);
#pragma unroll
  for (int mb = 0; mb < MB; ++mb)
#pragma unroll
    for (int nb2 = 0; nb2 < 2; ++nb2)
#pragma unroll
      for (int i = 0; i < 16; ++i) b[(32 * mb + crow0(i)) * ld + 32 * nb2] = f2bf(acc[mb][nb2][i] * rs_mul);
}
DI void store_bf16_t(const f32x16 (&acc)[MB][2], u16* dst, int ldt, int wm, int wn, int r, int h) {
  u16* b = dst + opq((64 * wn + r) * ldt + WMS * wm + 4 * h);
#pragma unroll
  for (int mb = 0; mb < MB; ++mb)
#pragma unroll
    for (int nb2 = 0; nb2 < 2; ++nb2)
#pragma unroll
      for (int q = 0; q < 4; ++q)
        *(uint2*)(b + 32 * nb2 * ldt + 32 * mb + 8 * q) = make_uint2(pack2(acc[mb][nb2][4 * q], acc[mb][nb2][4 * q + 1]), pack2(acc[mb][nb2][4 * q + 2], acc[mb][nb2][4 * q + 3]));
}

#define WAVE_IDS const int tid = otid(), wave = tid >> 6, lane = tid & 63, r = lane & 31, h = lane >> 5, wm = wave >> 1, wn = wave & 1; (void)tid; (void)wm; (void)wn; (void)r; (void)h;

DI void phase_even_in(const Params& p, int bid, int nb, char* smem) {
  WAVE_IDS
  char* ws = WS(p);
  GemmIn g{(const u16*)(ws + O_H), D_, S_ - 1, (const u16*)(ws + O_WIN), D_, D_};
  const float2* rt = (const float2*)(ws + O_ROPE);
  for (int it = 0;; ++it) {
    int mt, nt; if (!tile_coord(it, bid, nb, S_ / BM, 29, mt, nt)) break;
    f32x16 acc[MB][2];
    const int m0 = mt * BM;
    gemm_tile(g, m0, nt * 128, smem, acc);
    if (nt < 8) store_bf16(acc, (u16*)(ws + O_QN) + ((size_t)nt * S_ + m0) * 128, 128, wm, wn, r, h);
    else if (nt < 20) {
      const int c = nt - 8, br = c >> 2, kv = (c >> 1) & 1, gq = c & 1;
      if (br == 0) store_bf16(acc, (u16*)(ws + (kv ? O_VCS : O_KCS)) + ((size_t)gq * S_ + m0) * 128, 128, wm, wn, r, h);
      else if (kv == 0) store_bf16(acc, (u16*)(ws + (br == 1 ? O_KS : O_KW)) + ((size_t)gq * S_ + m0) * 128, 128, wm, wn, r, h);
      else store_bf16_t(acc, (u16*)(ws + (br == 1 ? O_VST : O_VWT)) + (size_t)gq * 128 * S_ + m0, S_, wm, wn, r, h);
    } else if (nt < 24) store_bf16(acc, (u16*)(ws + O_CQ) + (size_t)m0 * 512 + (nt - 20) * 128, 512, wm, wn, r, h);
    else if (nt < 28) store_bf16(acc, (u16*)(ws + O_CKV) + (size_t)m0 * 512 + (nt - 24) * 128, 512, wm, wn, r, h);
    else {
      float* kraw = (float*)(ws + O_KRAW) + opq((m0 + WMS * wm + 4 * h) * 88 + 64 * wn + r);
#pragma unroll
      for (int mb = 0; mb < MB; ++mb)
#pragma unroll
        for (int nb2 = 0; nb2 < 2; ++nb2)
          if (64 * wn + 32 * nb2 + r < 88) {
#pragma unroll
            for (int i = 0; i < 16; ++i) kraw[(32 * mb + crow0(i)) * 88 + 32 * nb2] = acc[mb][nb2][i];
          }
    }
  }
}

DI void rowscale_512(const u16* A, int m0, float* srs) {
  const int tid = otid();
  const u32x4* ar = (const u32x4*)(A + (size_t)(m0 + tid) * 512);
  float ss = 0.f;
#pragma unroll 8
  for (int i = 0; i < 64; ++i) {
    const u32x4 v = ar[i];
#pragma unroll
    for (int j = 0; j < 4; ++j) { const float a = __uint_as_float(v[j] << 16), b = __uint_as_float(v[j] & 0xffff0000u); ss += a * a + b * b; }
  }
  srs[tid] = rsqrtf(ss * (1.f / 512.f) + 1e-6f);
}

DI void phase_mla_up(const Params& p, int bid, int nb, char* smem) {
  WAVE_IDS
  char* ws = WS(p);
  float* srs = (float*)(smem + GEMM_LDS);
  const float2* rt = (const float2*)(ws + O_ROPE);
  {
    const float* kraw = (const float*)(ws + O_KRAW);
    u16* km = (u16*)(ws + O_KM);
    float* gt = (float*)(ws + O_GATES);
    for (int i = bid * 256 + tid; i < S_ * 32; i += nb * 256) {
      const int t = i >> 5, j = i & 31;
      const float x1 = kraw[t * 88 + j], x2 = kraw[t * 88 + 32 + j];
      const float2 cs = rt[i];
      const u16 o1 = f2bf(x1 * cs.x - x2 * cs.y), o2 = f2bf(x1 * cs.y + x2 * cs.x);
#pragma unroll
      for (int hd = 0; hd < 8; ++hd) { u16* d = km + ((size_t)hd * S_ + t) * 192 + 128 + j; d[0] = o1; d[32] = o2; }
      if (j < 24) gt[t * 24 + j] = sigmoidf(kraw[t * 88 + 64 + j] + p.gate_b[j]);
    }
  }
  if (bid < 64) {
    const int ks = bid >> 4, which = (bid >> 3) & 1, gq = (bid >> 2) & 1, mt = (bid >> 1) & 1, nt = bid & 1;
    GemmIn g{(const u16*)(ws + (which ? O_VCS : O_KCS)) + (size_t)gq * S_ * 128 + ks * 1024, 2048, 510, (const u16*)(ws + (which ? O_W1V : O_W1K)) + ks * 1024, 4096, 1024};
    f32x16 acc[MB][2];
    gemm_tile(g, mt * BM, nt * 128, smem, acc);
    float* dst = (float*)(ws + O_HCP) + ((size_t)((ks * 2 + which) * 2 + gq) * 512 + mt * BM) * 256 + nt * 128 + opq((WMS * wm + 4 * h) * 256 + 64 * wn + r);
#pragma unroll
    for (int mb = 0; mb < MB; ++mb)
#pragma unroll
      for (int nb2 = 0; nb2 < 2; ++nb2)
#pragma unroll
        for (int i = 0; i < 16; ++i) dst[(32 * mb + crow0(i)) * 256 + 32 * nb2] = acc[mb][nb2][i];
    return;
  }
  const int vb = bid - 64, vn = nb - 64;
  constexpr int MTS = S_ / BM;
  const int total = MTS * 12 + MTS * 16;
  for (int t = vb; t < total; t += vn) {
    f32x16 acc[MB][2];
    if (t < MTS * 12) {
      const int nt = t / MTS, mt = t % MTS, m0 = mt * BM;
      __syncthreads();
      rowscale_512((const u16*)(ws + O_CQ), m0, srs);
      GemmIn g{(const u16*)(ws + O_CQ), 512, S_ - 1, (const u16*)(ws + O_WUQ), 512, 512};
      gemm_tile(g, m0, nt * 128, smem, acc);
      u16* qm = (u16*)(ws + O_QM);
      const float* srb = srs + opq(WMS * wm + 4 * h);
      if (nt < 8) {
        u16* d = qm + (size_t)nt * S_ * 192 + opq((m0 + WMS * wm + 4 * h) * 192 + 64 * wn + r);
#pragma unroll
        for (int mb = 0; mb < MB; ++mb)
#pragma unroll
          for (int i = 0; i < 16; ++i) {
            const int rl = 32 * mb + crow0(i); const float rs = srb[rl];
#pragma unroll
            for (int nb2 = 0; nb2 < 2; ++nb2) d[rl * 192 + 32 * nb2] = f2bf(acc[mb][nb2][i] * rs);
          }
      } else {
        const int hd = 2 * (nt - 8) + wn;
        u16* d = qm + (size_t)hd * S_ * 192 + opq((m0 + WMS * wm + 4 * h) * 192 + 128 + r);
        const float2* rb = rt + opq((m0 + WMS * wm + 4 * h) * 32 + r);
#pragma unroll
        for (int mb = 0; mb < MB; ++mb) {
          float2 csv[16];
#pragma unroll
          for (int i = 0; i < 16; ++i) csv[i] = rb[(32 * mb + crow0(i)) * 32];
#pragma unroll
          for (int i = 0; i < 16; ++i) {
            const int rl = 32 * mb + crow0(i); const float rs = srb[rl];
            const float2 cs = csv[i];
            const float x1 = acc[mb][0][i] * rs, x2 = acc[mb][1][i] * rs;
            d[rl * 192] = f2bf(x1 * cs.x - x2 * cs.y); d[rl * 192 + 32] = f2bf(x1 * cs.y + x2 * cs.x);
          }
        }
      }
    } else {
      const int t2 = t - MTS * 12, nt = t2 / MTS, mt = t2 % MTS, m0 = mt * BM;
      __syncthreads();
      rowscale_512((const u16*)(ws + O_CKV), m0, srs);
      GemmIn g{(const u16*)(ws + O_CKV), 512, S_ - 1, (const u16*)(ws + O_WUKV), 512, 512};
      gemm_tile(g, m0, nt * 128, smem, acc);
      const int hd = nt >> 1;
#pragma unroll
      for (int mb = 0; mb < MB; ++mb)
#pragma unroll
        for (int i = 0; i < 16; ++i) { const float rs = srs[opq(WMS * wm + 4 * h) + 32 * mb + crow0(i)]; acc[mb][0][i] *= rs; acc[mb][1][i] *= rs; }
      if ((nt & 1) == 0) store_bf16(acc, (u16*)(ws + O_KM) + ((size_t)hd * S_ + m0) * 192, 192, wm, wn, r, h);
      else store_bf16_t(acc, (u16*)(ws + O_VMT) + (size_t)hd * 128 * S_ + m0, S_, wm, wn, r, h);
    }
  }
}

DI void phase_cmp_out(const Params& p, int bid, int nb, char* smem) {
  WAVE_IDS
  char* ws = WS(p);
  for (int t = bid; t < 8; t += nb) {
    const int which = t >> 2, gq = (t >> 1) & 1, mt = t & 1;
    {
      const float* hp = (const float*)(ws + O_HCP) + ((size_t)(which * 2 + gq) * 512 + mt * BM) * 256;
      const float* c1 = (const float*)(ws + O_C1) + which * 256;
      u16* hc = (u16*)(ws + O_HC) + ((size_t)(which * 2 + gq) * 512 + mt * BM) * 256;
      const float4 cb = *(const float4*)(c1 + ((tid * 4) & 255));
      for (int e0 = tid * 4; e0 < BM * 256; e0 += 256 * 4 * 8) {
        float4 a[8];
#pragma unroll
        for (int u = 0; u < 8; ++u) a[u] = *(const float4*)(hp + e0 + u * 1024);
#pragma unroll
        for (int ks = 1; ks < 4; ++ks)
#pragma unroll
          for (int u = 0; u < 8; ++u) { const float4 b = *(const float4*)(hp + (size_t)ks * 4 * 512 * 256 + e0 + u * 1024); a[u].x += b.x; a[u].y += b.y; a[u].z += b.z; a[u].w += b.w; }
#pragma unroll
        for (int u = 0; u < 8; ++u)
          *(uint2*)(hc + e0 + u * 1024) = make_uint2(pack2(siluf(a[u].x + cb.x), siluf(a[u].y + cb.y)), pack2(siluf(a[u].z + cb.z), siluf(a[u].w + cb.w)));
      }
      __threadfence();
      __syncthreads();
    }
    GemmIn g{(const u16*)(ws + O_HC) + (size_t)(which * 2 + gq) * 512 * 256, 256, 511, (const u16*)(ws + (which ? O_W2V : O_W2K)), 256, 256};
    f32x16 acc[MB][2];
    gemm_tile(g, mt * BM, 0, smem, acc);
    if (which == 0) store_bf16(acc, (u16*)(ws + O_KC) + ((size_t)gq * 512 + mt * BM) * 128, 128, wm, wn, r, h);
    else store_bf16_t(acc, (u16*)(ws + O_VCT) + (size_t)gq * 128 * 512 + mt * BM, 512, wm, wn, r, h);
  }
}

DI void phase_resid(const Params& p, const u16* A, int K, const u16* Bt, const float* xin, const float* gate, float* xout, int bid, int nb, char* smem) {
  WAVE_IDS
  GemmIn g{A, K, S_ - 1, Bt, K, K};
  for (int it = 0;; ++it) {
    int mt, nt; if (!tile_coord(it, bid, nb, S_ / BM, 16, mt, nt)) break;
    f32x16 acc[MB][2];
    const int m0 = mt * BM, n0 = nt * 128;
    gemm_tile(g, m0, n0, smem, acc);
    const int ob = opq((m0 + WMS * wm + 4 * h) * D_ + n0 + 64 * wn + r);
    const float* xi = xin + ob; float* xo = xout + ob;
#pragma unroll
    for (int mb = 0; mb < MB; ++mb)
#pragma unroll
      for (int nb2 = 0; nb2 < 2; ++nb2) {
        const float gv = gate[n0 + 64 * wn + 32 * nb2 + r];
        float xv[16];
#pragma unroll
        for (int i = 0; i < 16; ++i) xv[i] = xi[(32 * mb + crow0(i)) * D_ + 32 * nb2];
#pragma unroll
        for (int i = 0; i < 16; ++i) xo[(32 * mb + crow0(i)) * D_ + 32 * nb2] = xv[i] + gv * acc[mb][nb2][i];
      }
  }
}

DI void phase_ffn_up(const Params& p, const u16* W13, int bid, int nb, char* smem) {
  WAVE_IDS
  GemmIn g{(const u16*)(WS(p) + O_H), D_, S_ - 1, W13, D_, D_};
  u16* U = (u16*)(WS(p) + O_U);
  for (int it = 0;; ++it) {
    int mt, nt; if (!tile_coord(it, bid, nb, S_ / BM, 88, mt, nt)) break;
    f32x16 acc[MB][2];
    const int m0 = mt * BM;
    gemm_tile(g, m0, nt * 128, smem, acc);
    u16* ub = U + (size_t)m0 * F_ + opq((WMS * wm + 4 * h) * F_ + 32 * (2 * nt + wn) + r);
#pragma unroll
    for (int mb = 0; mb < MB; ++mb)
#pragma unroll
      for (int i = 0; i < 16; ++i) ub[(32 * mb + crow0(i)) * F_] = f2bf(siluf(acc[mb][0][i]) * acc[mb][1][i]);
  }
}

DI void phase_fox_in(const Params& p, int bid, int nb, char* smem) {
  WAVE_IDS
  char* ws = WS(p);
  float* red = (float*)(smem + GEMM_LDS);
  GemmIn g{(const u16*)(ws + O_H), D_, S_ - 1, (const u16*)(ws + O_WFIN), D_, D_};
  for (int it = 0;; ++it) {
    int mt, nt; if (!tile_coord(it, bid, nb, S_ / BM, 64, mt, nt)) break;
    f32x16 acc[MB][2];
    const int m0 = mt * BM;
    gemm_tile(g, m0, nt * 128, smem, acc);
    if (nt < 32) {
      const float* gn = (nt < 16) ? p.fox_q_norm : p.fox_k_norm;
#pragma unroll
      for (int mb = 0; mb < MB; ++mb)
#pragma unroll
        for (int i = 0; i < 16; ++i) {
          if ((i & 3) == 0) SB0;
          float ss = acc[mb][0][i] * acc[mb][0][i] + acc[mb][1][i] * acc[mb][1][i];
#pragma unroll
          for (int o = 16; o >= 1; o >>= 1) ss += __shfl_xor(ss, o, 64);
          if (r == 0) red[opq(wn * BM + WMS * wm + 4 * h) + 32 * mb + crow0(i)] = ss;
        }
      __syncthreads();
      const float g0 = gn[64 * wn + r], g1 = gn[64 * wn + 32 + r];
      u16* dst = (u16*)(ws + (nt < 16 ? O_QF : O_KF)) + ((size_t)(nt & 15) * S_ + m0) * 128 + opq((WMS * wm + 4 * h) * 128 + 64 * wn + r);
      const float* rdb = red + opq(WMS * wm + 4 * h);
#pragma unroll
      for (int mb = 0; mb < MB; ++mb)
#pragma unroll
        for (int i = 0; i < 16; ++i) {
          const int rl = 32 * mb + crow0(i);
          const float rstd = rsqrtf((rdb[rl] + rdb[BM + rl]) * (1.f / 128.f) + 1e-6f);
          dst[rl * 128] = f2bf(acc[mb][0][i] * rstd * g0);
          dst[rl * 128 + 32] = f2bf(acc[mb][1][i] * rstd * g1);
        }
      __syncthreads();
    } else if (nt < 48) store_bf16_t(acc, (u16*)(ws + O_VFT) + (size_t)(nt - 32) * 128 * S_ + m0, S_, wm, wn, r, h);
    else store_bf16(acc, (u16*)(ws + O_OG) + (size_t)m0 * D_ + (nt - 48) * 128, D_, wm, wn, r, h);
  }
  for (int e = bid; e < 4 * (S_ / BM); e += nb) {
    const int mt = e >> 2, ks = e & 3, m0 = mt * BM;
    GemmIn gf{(const u16*)(ws + O_H) + ks * 512, D_, S_ - 1, (const u16*)(ws + O_WFIN) + (size_t)8192 * D_ + ks * 512, D_, 512};
    f32x16 acc[MB][2];
    gemm_tile(gf, m0, 0, smem, acc);
    if (wn == 0 && r < 16) {
      float* fl = (float*)(ws + O_FL) + (size_t)ks * S_ * 16 + opq((m0 + WMS * wm + 4 * h) * 16 + r);
#pragma unroll
      for (int mb = 0; mb < MB; ++mb)
#pragma unroll
        for (int i = 0; i < 16; ++i) fl[(32 * mb + crow0(i)) * 16] = acc[mb][0][i];
    }
  }
}

DI void phase_cumsum(const Params& p, int bid, int nb, char* smem) {
  float* sw = (float*)smem;
  const int tid = otid(), lane = tid & 63, wave = tid >> 6;
  const float* fl = (const float*)(WS(p) + O_FL);
  for (int hd = bid; hd < 16; hd += nb) {
    float v[32]; float s = 0.f;
    const float fb = p.fox_f_b[hd];
#pragma unroll
    for (int i = 0; i < 32; ++i) {
      const size_t o = (size_t)(tid * 32 + i) * 16 + hd;
      const float z = ((fl[o] + fl[o + (size_t)S_ * 16]) + (fl[o + (size_t)2 * S_ * 16] + fl[o + (size_t)3 * S_ * 16])) + fb;
      s += fminf(z, 0.f) - __logf(1.f + __expf(-fabsf(z)));
      v[i] = s;
    }
    float inc = s;
#pragma unroll
    for (int o = 1; o < 64; o <<= 1) { const float t = __shfl_up(inc, o, 64); if (lane >= o) inc += t; }
    __syncthreads();
    if (lane == 63) sw[wave] = inc;
    __syncthreads();
    float base = inc - s;
    for (int w = 0; w < wave; ++w) base += sw[w];
    float* cum = (float*)(WS(p) + O_CUM) + (size_t)hd * S_ + tid * 32;
#pragma unroll
    for (int i = 0; i < 32; ++i) cum[i] = base + v[i];
  }
}

constexpr int VST = 68;
enum { MODE_WIN = 0, MODE_SEL = 1, MODE_MLA = 2, MODE_FOX = 3, MODE_CMP = 4 };

template <int DQK>
DI void load_k_tile(const u16* K, int key0, u16* sK) {
  constexpr int KST = DQK + 8;
  const int tid = otid();
  const u16* gp = K + (size_t)key0 * DQK + opq((tid >> 3) * DQK + (tid & 7) * 8);
  u16* lp = sK + opq((tid >> 3) * KST + (tid & 7) * 8);
#pragma unroll
  for (int i = 0; i < DQK / 32; ++i)
    *(u32x4*)(lp + 32 * (i & 1) * KST + 64 * (i >> 1)) = *(const u32x4*)(gp + 32 * (i & 1) * DQK + 64 * (i >> 1));
}
DI void load_vt_tile(const u16* Vt, int ldv, int key0, u16* sV) {
  const int tid = otid();
  const u16* gp = Vt + key0 + opq((tid >> 3) * ldv + (tid & 7) * 8);
  u16* lp = sV + opq((tid >> 3) * VST + (tid & 7) * 8);
#pragma unroll
  for (int i = 0; i < 4; ++i) {
    const u32x4 v = *(const u32x4*)(gp + 32 * i * ldv);
    *(u32x2*)(lp + 32 * i * VST) = u32x2{v.x, v.y};
    *(u32x2*)(lp + 32 * i * VST + 4) = u32x2{v.z, v.w};
  }
}
template <int DQK>
DI void qk_tile(const u16* sK, const bf16x8 (&qf)[DQK / 16], f32x16 (&s)[2], int r, int h) {
  constexpr int KST = DQK + 8;
  constexpr int NKS = DQK / 16;
  const u16* kp = sK + opq(r * KST + 8 * h);
#pragma unroll
  for (int kb = 0; kb < 2; ++kb) {
#pragma unroll
    for (int i = 0; i < 16; ++i) s[kb][i] = 0.f;
#pragma unroll
    for (int c0 = 0; c0 < NKS; c0 += 8) {
      constexpr int CH = 8;
      bf16x8 kf[CH];
#pragma unroll
      for (int j = 0; j < CH; ++j) if (c0 + j < NKS) kf[j] = *(const bf16x8*)(kp + 32 * kb * KST + 16 * (c0 + j));
      SB0;
#pragma unroll
      for (int j = 0; j < CH; ++j) if (c0 + j < NKS) s[kb] = MFMA32(kf[j], qf[c0 + j], s[kb]);
    }
  }
}
DI void pv_tile(const u16* sV, const f32x16 (&s)[2], f32x16 (&o)[4], int r, int h) {
  const u16* vb = sV + opq(r * VST + 4 * h);
#pragma unroll
  for (int kb = 0; kb < 2; ++kb) {
    bf16x8 pf[2]; bf16x8 vf[2][4];
#pragma unroll
    for (int s2 = 0; s2 < 2; ++s2) {
      pf[s2] = pack8(s[kb], s2);
#pragma unroll
      for (int db = 0; db < 4; ++db) {
        const u16* vp = vb + 32 * db * VST + 32 * kb + 16 * s2;
        const s16x4 lo = *(const s16x4*)vp, hi = *(const s16x4*)(vp + 8);
        vf[s2][db] = __builtin_shufflevector(lo, hi, 0, 1, 2, 3, 4, 5, 6, 7);
      }
    }
    SB0;
#pragma unroll
    for (int s2 = 0; s2 < 2; ++s2)
#pragma unroll
      for (int db = 0; db < 4; ++db) o[db] = MFMA32(vf[s2][db], pf[s2], o[db]);
  }
}

DI void topk_item(const Params& p, int qt, int gq) {
  WAVE_IDS
  char* ws = WS(p);
  const int tq = qt * 128 + wave * 32 + r;
  const int head = gq * 4;
  u32 selw[4] = {0, 0, 0, 0};
    float A[64];
    {
      const float* ib = (const float*)(ws + O_IMP) + (((size_t)(head & ~3) * S_ + tq) * 2 + h) * 64;
#pragma unroll
      for (int j = 0; j < 16; ++j) { const float4 v = *(const float4*)(ib + 4 * j); A[4 * j] = v.x; A[4 * j + 1] = v.y; A[4 * j + 2] = v.z; A[4 * j + 3] = v.w; }
#pragma unroll 1
      for (int rr = 1; rr < 4; ++rr) {
        const float* ib2 = ib + (size_t)rr * S_ * 128;
#pragma unroll
        for (int j = 0; j < 16; ++j) { const float4 v = *(const float4*)(ib2 + 4 * j); A[4 * j] += v.x; A[4 * j + 1] += v.y; A[4 * j + 2] += v.z; A[4 * j + 3] += v.w; }
      }
    }
    const int cur = tq >> 6;
    const int lim2 = opq(cur - 2 - h);
#pragma unroll
    for (int si = 0; si < 64; ++si) { if ((si == 0 && h == 0) || (2 * si > lim2)) A[si] = -3e38f; }
    auto setbit = [&](int J) { const u32 b = 1u << (J & 31); const int w = J >> 5; if (w == 0) selw[0] |= b; else if (w == 1) selw[1] |= b; else if (w == 2) selw[2] |= b; else selw[3] |= b; };
    setbit(0); setbit(cur); if (cur >= 1) setbit(cur - 1);
    for (int round = 0; round < 13; ++round) {
      float best = -3e38f; int bi = 0;
#pragma unroll
      for (int si = 0; si < 64; ++si) { if (A[si] > best) { best = A[si]; bi = si; } }
      const int bj = 2 * bi + h;
      const float ob = shx32(best); const int oj = __shfl_xor(bj, 32, 64);
      const bool takeo = (ob > best) || (ob == best && oj < bj);
      const float wv = takeo ? ob : best; const int wj = takeo ? oj : bj;
      if (wv > -1e30f) {
        setbit(wj);
        if (!takeo) {
#pragma unroll
          for (int si = 0; si < 64; ++si) if (si == bi) A[si] = -3e38f;
        }
      }
    }
    if (h == 0) *(uint4*)((u32*)(ws + O_SELM) + ((size_t)gq * S_ + tq) * 4) = make_uint4(selw[0], selw[1], selw[2], selw[3]);
}

DI int next_sel(const u32* sun, int kt, int kt_hi) {
  int k = kt + 1;
  while (k < kt_hi) {
    const u32 w = __builtin_amdgcn_readfirstlane(sun[k >> 5]) >> (k & 31);
    if (w) return k + __builtin_ctz(w);
    k = (k | 31) + 1;
  }
  return kt_hi;
}

template <int MODE>
DI void attn_item(const Params& p, int qt, int head, char* smem) {
  constexpr int DQK = (MODE == MODE_MLA) ? 192 : 128;
  constexpr int KST = DQK + 8;
  constexpr int NI = DQK / 32;
  constexpr bool HAS_T5 = (MODE == MODE_WIN || MODE == MODE_SEL || MODE == MODE_CMP);
  constexpr bool HAS_AUX = HAS_T5 || MODE == MODE_FOX;
  u16* sK = (u16*)smem; u16* sV = sK + 64 * KST;
  int* spos = (int*)(sV + 128 * VST);
  float* stbl = (float*)(spos + 64);
  int* sthr = (int*)(stbl + 32);
  u32* sun = (u32*)(sthr + 32);
  int* smm = (int*)(sun + 4);
  u32* ssel = (u32*)(smm + 4);
  WAVE_IDS
  char* ws = WS(p);
  const int qs = qt * 128, tq = qs + wave * 32 + r;
  const u16 *Q, *K, *Vt; float sc2; int ldv = S_;
  if (MODE == MODE_WIN) { Q = (const u16*)(ws + O_QN) + (size_t)head * S_ * 128; K = (const u16*)(ws + O_KW) + (size_t)(head >> 2) * S_ * 128; Vt = (const u16*)(ws + O_VWT) + (size_t)(head >> 2) * 128 * S_; sc2 = 0.08838834764831845f * LOG2E; }
  else if (MODE == MODE_SEL) { Q = (const u16*)(ws + O_QN) + (size_t)head * S_ * 128; K = (const u16*)(ws + O_KS) + (size_t)(head >> 2) * S_ * 128; Vt = (const u16*)(ws + O_VST) + (size_t)(head >> 2) * 128 * S_; sc2 = 0.08838834764831845f * LOG2E; }
  else if (MODE == MODE_CMP) { Q = (const u16*)(ws + O_QN) + (size_t)head * S_ * 128; K = (const u16*)(ws + O_KC) + (size_t)(head >> 2) * 512 * 128; Vt = (const u16*)(ws + O_VCT) + (size_t)(head >> 2) * 128 * 512; sc2 = 0.08838834764831845f * LOG2E; ldv = 512; }
  else if (MODE == MODE_MLA) { Q = (const u16*)(ws + O_QM) + (size_t)head * S_ * 192; K = (const u16*)(ws + O_KM) + (size_t)head * S_ * 192; Vt = (const u16*)(ws + O_VMT) + (size_t)head * 128 * S_; sc2 = 0.07216878364870322f * LOG2E; }
  else { Q = (const u16*)(ws + O_QF) + (size_t)head * S_ * 128; K = (const u16*)(ws + O_KF) + (size_t)head * S_ * 128; Vt = (const u16*)(ws + O_VFT) + (size_t)head * 128 * S_; sc2 = 0.08838834764831845f * LOG2E; }

  __syncthreads();
  if (HAS_T5 && tid < 32) { stbl[tid] = p.rel_bias[tid * 8 + head] * LOG2E; sthr[tid] = p.t5thr[tid]; }
  u32 selw[4] = {0, 0, 0, 0};
  if (MODE == MODE_SEL) {
    if (tid < 4) sun[tid] = 0;
    { const uint4 m4 = *(const uint4*)((const u32*)(ws + O_SELM) + ((size_t)(head >> 2) * S_ + tq) * 4); selw[0] = m4.x; selw[1] = m4.y; selw[2] = m4.z; selw[3] = m4.w; }
    __syncthreads();
    if (h == 0) { atomicOr(&sun[0], selw[0]); atomicOr(&sun[1], selw[1]); atomicOr(&sun[2], selw[2]); atomicOr(&sun[3], selw[3]); }
    ssel[tid] = selw[0]; ssel[256 + tid] = selw[1]; ssel[512 + tid] = selw[2]; ssel[768 + tid] = selw[3];
  }
  bf16x8 qf[DQK / 16];
#pragma unroll
  for (int ks = 0; ks < DQK / 16; ++ks) qf[ks] = *(const bf16x8*)(Q + (size_t)tq * DQK + 16 * ks + 8 * h);
  const int pq = HAS_T5 ? p.pos[tq] : 0;
  f32x16 o[4];
#pragma unroll
  for (int db = 0; db < 4; ++db)
#pragma unroll
    for (int i = 0; i < 16; ++i) o[db][i] = 0.f;
  float m = NEGB, l = 0.f;
  int kt_lo = 0; int kt_hi = (qs + 128) >> 6;
  if (MODE == MODE_WIN) { kt_lo = (qs - 512) >> 6; kt_lo = kt_lo < 0 ? 0 : kt_lo; }
  if (MODE == MODE_CMP) { const int tmax = qs + 127; const int nvis = ((tmax - 31) >> 4) + 1; kt_hi = (nvis + 63) >> 6; }
  __syncthreads();

  const int kgo = opq((tid >> 3) * DQK + (tid & 7) * 8), klo = opq((tid >> 3) * KST + (tid & 7) * 8);
  const int vgo = opq((tid >> 3) * ldv + (tid & 7) * 8), vlo = opq((tid >> 3) * VST + (tid & 7) * 8);
  u32x4 kreg[NI], vreg[4]; int areg = 0;
  auto issue = [&](int kt, bool withV = true) __attribute__((always_inline)) {
    const u16* gk = K + (size_t)kt * 64 * DQK + kgo;
#pragma unroll
    for (int i = 0; i < NI; ++i) kreg[i] = *(const u32x4*)(gk + 32 * (i & 1) * DQK + 64 * (i >> 1));
    if (withV) {
      const u16* gv = Vt + kt * 64 + vgo;
#pragma unroll
      for (int i = 0; i < 4; ++i) vreg[i] = *(const u32x4*)(gv + 32 * i * ldv);
    }
    if (HAS_AUX && tid < 64) {
      if (MODE == MODE_CMP) { int idx = 16 * (kt * 64 + tid) + 31; idx = idx > S_ - 1 ? S_ - 1 : idx; areg = p.pos[idx]; }
      else if (MODE == MODE_FOX) areg = __float_as_int(-LOG2E * ((const float*)(ws + O_CUM))[(size_t)head * S_ + kt * 64 + tid]);
      else areg = p.pos[kt * 64 + tid];
    }
  };
  auto stash = [&](bool withV = true) __attribute__((always_inline)) {
#pragma unroll
    for (int i = 0; i < NI; ++i) *(u32x4*)(sK + klo + 32 * (i & 1) * KST + 64 * (i >> 1)) = kreg[i];
    if (withV) {
#pragma unroll
      for (int i = 0; i < 4; ++i) { *(u32x2*)(sV + vlo + 32 * i * VST) = u32x2{vreg[i].x, vreg[i].y}; *(u32x2*)(sV + vlo + 32 * i * VST + 4) = u32x2{vreg[i].z, vreg[i].w}; }
    }
    if (HAS_AUX && tid < 64) {
      spos[tid] = areg;
      if (HAS_T5) {
        int mn = areg, mx = areg;
#pragma unroll
        for (int o2 = 32; o2 >= 1; o2 >>= 1) { mn = min(mn, __shfl_xor(mn, o2, 64)); mx = max(mx, __shfl_xor(mx, o2, 64)); }
        if (tid == 0) { smm[0] = mn; smm[1] = mx; }
      }
    }
  };
  auto logits = [&](f32x16 (&s)[2], int kt, bool mysel, bool full) __attribute__((always_inline)) {
    qk_tile<DQK>(sK, qf, s, r, h);
    const int k0 = kt * 64;
    const int rel = (MODE == MODE_CMP) ? opq(tq - 31 - 16 * (k0 + 4 * h)) : opq(tq - k0 - 4 * h);
    const int* sposb = spos + opq(4 * h);
    bool fast = false; int thr = 0; float tb0 = 0.f, tb1 = 0.f;
    if (HAS_T5) {
      const int b0 = t5_bucket(pq - smm[1]), b1 = t5_bucket(pq - smm[0]);
      fast = (__ballot((b1 - b0) > 1) == 0ull);
      thr = sthr[b1]; tb0 = stbl[b0]; tb1 = stbl[b1];
    }
    if (HAS_T5 && !fast) {
#pragma unroll
      for (int kb = 0; kb < 2; ++kb)
#pragma unroll
        for (int i = 0; i < 16; ++i) { const int c = 32 * kb + crow0(i); s[kb][i] = s[kb][i] * sc2 + stbl[t5_bucket(pq - sposb[c])]; }
    } else {
#pragma unroll
      for (int kb = 0; kb < 2; ++kb)
#pragma unroll
        for (int i = 0; i < 16; ++i) {
          const int c = 32 * kb + crow0(i);
          float v = s[kb][i] * sc2;
          if (HAS_T5) v += ((pq - sposb[c]) >= thr) ? tb1 : tb0;
          if (MODE == MODE_FOX) v += ((const float*)sposb)[c];
          s[kb][i] = v;
        }
    }
    if (!full) {
#pragma unroll
      for (int kb = 0; kb < 2; ++kb)
#pragma unroll
        for (int i = 0; i < 16; ++i) {
          const int c = 32 * kb + crow0(i);
          bool valid;
          if (MODE == MODE_CMP) valid = (16 * c <= rel);
          else valid = (c <= rel);
          if (MODE == MODE_WIN) valid = valid && (rel < 512 + c);
          if (MODE == MODE_SEL) valid = valid && mysel;
          s[kb][i] = valid ? s[kb][i] : NEGB;
        }
    }
  };
  const int tq0 = qs + wave * 32;
  auto tile_full = [&](int kt) __attribute__((always_inline)) -> bool {
    const int k0 = kt * 64;
    bool f;
    if (MODE == MODE_CMP) f = (16 * (k0 + 63) + 31 <= tq0);
    else f = (k0 + 63 <= tq0);
    if (MODE == MODE_WIN) f = f && (tq0 + 31 - k0 < 512);
    return __builtin_amdgcn_readfirstlane((int)f) != 0;
  };

  constexpr bool PF = false;
  constexpr bool REV = (MODE == MODE_FOX);
  int kt = REV ? kt_hi - 1 : kt_lo;
  if (MODE == MODE_SEL) kt = next_sel(sun, -1, kt_hi);
  if (PF && kt < kt_hi) issue(kt);
  while (REV ? (kt >= kt_lo) : (kt < kt_hi)) {
    __syncthreads();
    if (!PF) issue(kt);
    stash();
    __syncthreads();
    const int ktn = (MODE == MODE_SEL) ? next_sel(sun, kt, kt_hi) : (REV ? kt - 1 : kt + 1);
    if (PF && (REV ? (ktn >= kt_lo) : (ktn < kt_hi))) issue(ktn);
    bool mysel = true;
    if (MODE == MODE_SEL) mysel = (ssel[(kt >> 5) * 256 + tid] >> (kt & 31)) & 1;
    const unsigned long long selb = (MODE == MODE_SEL) ? __ballot(mysel) : ~0ull;
    if (selb != 0ull) {
      f32x16 s[2];
      const bool full = HAS_T5 ? false : tile_full(kt);
      logits(s, kt, mysel, full);
      float mx = NEGB;
#pragma unroll
      for (int kb = 0; kb < 2; ++kb)
#pragma unroll
        for (int i = 0; i < 16; ++i) mx = fmaxf(mx, s[kb][i]);
      mx = fmaxf(mx, shx32(mx));
      const float mn = fmaxf(m, mx);
      const float alpha = fexp2(m - mn);
      float ps = 0.f;
#pragma unroll
      for (int kb = 0; kb < 2; ++kb)
#pragma unroll
        for (int i = 0; i < 16; ++i) { const float v = s[kb][i]; const float e = (v > -1e29f) ? fexp2(v - mn) : 0.f; s[kb][i] = e; ps += e; }
      l = l * alpha + ps;
      if (__ballot(mn > m) != 0ull) {
#pragma unroll
        for (int db = 0; db < 4; ++db)
#pragma unroll
          for (int i = 0; i < 16; ++i) o[db][i] *= alpha;
      }
      m = mn;
      pv_tile(sV, s, o, r, h);
    }
    kt = ktn;
  }
  l += shx32(l);
  const float inv = l > 0.f ? 1.f / l : 0.f;
  if (MODE == MODE_WIN || MODE == MODE_CMP) {
    const float gw = ((const float*)(ws + O_GATES))[(size_t)tq * 24 + head * 3 + (MODE == MODE_WIN ? 2 : 0)] * inv;
    float* ow = (float*)(ws + (MODE == MODE_WIN ? O_OW : O_OC)) + opq(tq * 1024 + head * 128 + 4 * h);
#pragma unroll
    for (int db = 0; db < 4; ++db) {
#pragma unroll
      for (int q = 0; q < 4; ++q) *(float4*)(ow + 32 * db + 8 * q) = make_float4(o[db][4 * q] * gw, o[db][4 * q + 1] * gw, o[db][4 * q + 2] * gw, o[db][4 * q + 3] * gw);
    }
  } else if (MODE == MODE_SEL) {
    const float gs = ((const float*)(ws + O_GATES))[(size_t)tq * 24 + head * 3 + 1] * inv;
    const int ob_ = opq(tq * 1024 + head * 128 + 4 * h);
    const float* oc = (const float*)(ws + O_OC) + ob_;
    const float* ow = (const float*)(ws + O_OW) + ob_;
    u16* mix = (u16*)(ws + O_MIX) + opq(tq * D_ + head * 128 + 4 * h);
#pragma unroll
    for (int db = 0; db < 4; ++db) {
      float4 a[4], b[4];
#pragma unroll
      for (int q = 0; q < 4; ++q) { a[q] = *(const float4*)(oc + 32 * db + 8 * q); b[q] = *(const float4*)(ow + 32 * db + 8 * q); }
#pragma unroll
      for (int q = 0; q < 4; ++q)
        *(uint2*)(mix + 32 * db + 8 * q) = make_uint2(pack2(a[q].x + b[q].x + o[db][4 * q] * gs, a[q].y + b[q].y + o[db][4 * q + 1] * gs), pack2(a[q].z + b[q].z + o[db][4 * q + 2] * gs, a[q].w + b[q].w + o[db][4 * q + 3] * gs));
    }
  } else if (MODE == MODE_MLA) {
    u16* mix = (u16*)(ws + O_MIX) + opq(tq * D_ + 1024 + head * 128 + 4 * h);
#pragma unroll
    for (int db = 0; db < 4; ++db)
#pragma unroll
      for (int q = 0; q < 4; ++q)
        *(uint2*)(mix + 32 * db + 8 * q) = make_uint2(pack2(o[db][4 * q] * inv, o[db][4 * q + 1] * inv), pack2(o[db][4 * q + 2] * inv, o[db][4 * q + 3] * inv));
  } else {
    const int ob_ = opq(tq * D_ + head * 128 + 4 * h);
    const u16* og = (const u16*)(ws + O_OG) + ob_;
    u16* mix = (u16*)(ws + O_MIX) + ob_;
    uint2 gall[16];
#pragma unroll
    for (int j = 0; j < 16; ++j) gall[j] = *(const uint2*)(og + 8 * j);
#pragma unroll
    for (int db = 0; db < 4; ++db)
#pragma unroll
      for (int q = 0; q < 4; ++q) {
        const int dv = 32 * db + 8 * q;
        const uint2 gv = gall[4 * db + q];
        const float g0 = sigmoidf(__uint_as_float(gv.x << 16)), g1 = sigmoidf(__uint_as_float(gv.x & 0xffff0000u));
        const float g2 = sigmoidf(__uint_as_float(gv.y << 16)), g3 = sigmoidf(__uint_as_float(gv.y & 0xffff0000u));
        *(uint2*)(mix + dv) = make_uint2(pack2(o[db][4 * q] * inv * g0, o[db][4 * q + 1] * inv * g1), pack2(o[db][4 * q + 2] * inv * g2, o[db][4 * q + 3] * inv * g3));
      }
  }
  if (MODE == MODE_CMP) {
    float A[64];
#pragma unroll
    for (int i = 0; i < 64; ++i) A[i] = 0.f;
    for (int kt2 = 0; kt2 < kt_hi; ++kt2) {
      __syncthreads();
      issue(kt2, false);
      stash(false);
      __syncthreads();
      f32x16 s[2];
      logits(s, kt2, true, false);
      float loc[9];
#pragma unroll
      for (int i = 0; i < 9; ++i) loc[i] = 0.f;
#pragma unroll
      for (int kb = 0; kb < 2; ++kb)
#pragma unroll
        for (int q = 0; q < 4; ++q) {
          float e[4];
#pragma unroll
          for (int j = 0; j < 4; ++j) { const float v = s[kb][4 * q + j]; e[j] = (v > -1e29f) ? fexp2(v - m) * inv : 0.f; }
          const float g4 = (e[0] + e[1]) + (e[2] + e[3]);
          const float other = shx32(e[3]);
          loc[4 * kb + q] += g4 + (h ? other : 0.f);
          loc[4 * kb + q + 1] += (h ? 0.f : other);
        }
#pragma unroll
      for (int kk = 0; kk < 8; ++kk) {
        if (kk == kt2) {
#pragma unroll
          for (int j = 0; j < 8; ++j) A[8 * kk + j] += loc[j];
          if (8 * kk + 8 < 64) A[8 * kk + 8] += loc[8];
        }
      }
    }
    float* ib = (float*)(ws + O_IMP) + (((size_t)head * S_ + tq) * 2 + h) * 64;
#pragma unroll
    for (int j = 0; j < 16; ++j) *(float4*)(ib + 4 * j) = make_float4(A[4 * j], A[4 * j + 1], A[4 * j + 2], A[4 * j + 3]);
  }
}

DI void phase_attn_a(const Params& p, int bid, int nb, char* smem) {
  __shared__ uint4 s_item;
  const int xcd = bid & 7;
  unsigned* ctr = (unsigned*)(WS(p) + O_BAR) + 10 + xcd;
  (void)nb;
  while (true) {
    __syncthreads();
    if (threadIdx.x == 0) s_item.x = atomicAdd(ctr, 1u);
    __syncthreads();
    const int it = __builtin_amdgcn_readfirstlane((int)s_item.x);
    if (it >= 128) break;
    if (it < 64) attn_item<MODE_CMP>(p, 63 - it, xcd, smem);
    else attn_item<MODE_WIN>(p, 127 - it, xcd, smem);
  }
}
DI void phase_topk(const Params& p, int bid, int nb) {
  for (int it = bid; it < 128; it += nb) topk_item(p, it >> 1, it & 1);
}
DI void phase_attn_b(const Params& p, int bid, int nb, char* smem) {
  const int xcd = bid & 7, slot = bid >> 3, per = nb >> 3;
  for (int s = slot; s < 64; s += per) {
#if !defined(DIAGQ) || DIAGQ == 1
    attn_item<MODE_MLA>(p, 63 - s, xcd, smem);
#endif
#if !defined(DIAGQ) || DIAGQ == 2
    attn_item<MODE_SEL>(p, s, xcd, smem);
#endif
  }
}
DI void phase_attn_fox(const Params& p, int bid, int nb, char* smem) {
  const int xcd = bid & 7, slot = bid >> 3, per = nb >> 3;
  for (int s = slot; s < 64; s += per) {
    attn_item<MODE_FOX>(p, 63 - s, 2 * xcd, smem);
    attn_item<MODE_FOX>(p, s, 2 * xcd + 1, smem);
  }
}

constexpr int NPHASE = 20;
constexpr int NPROG = 22;
__device__ __constant__ int c_prog[NPROG] = {0, 1, 2, 3, 4, 5, 6, 21, 7, 8, 9, 10, 11, 12, 13, 14, 15, 16, 17, 18, 19, 20};
DI void run_phase(const Params& p, int ph, int bid, int nb, char* smem) {
  char* ws = WS(p);
  const float* mod = (const float*)(ws + O_MOD);
  float* X1 = (float*)(ws + O_X1);
  switch (ph) {
    case 0: phase_prep(p, bid, nb, smem); break;
    case 1: phase_fin(p, bid, nb); break;
    case 2: phase_norm(p.x, p.norm_mix, mod + 2048, mod, (u16*)(ws + O_H), nullptr, bid, nb); break;
    case 3: phase_even_in(p, bid, nb, smem); break;
    case 4: phase_mla_up(p, bid, nb, smem); break;
    case 5: phase_cmp_out(p, bid, nb, smem); break;
    case 6: phase_attn_a(p, bid, nb, smem); break;
    case 7: phase_attn_b(p, bid, nb, smem); break;
    case 21: phase_topk(p, bid, nb); break;
    case 8: phase_resid(p, (const u16*)(ws + O_MIX), 2048, (const u16*)(ws + O_WOUT), p.x, mod + 4096, X1, bid, nb, smem); break;
    case 9: phase_norm(X1, p.norm_ffn, mod + 4 * 2048, mod + 3 * 2048, (u16*)(ws + O_H), nullptr, bid, nb); break;
    case 10: phase_ffn_up(p, (const u16*)(ws + O_W13_0), bid, nb, smem); break;
    case 11: phase_resid(p, (const u16*)(ws + O_U), F_, (const u16*)(ws + O_W2_0), X1, mod + 5 * 2048, X1, bid, nb, smem); break;
    case 12: phase_norm(X1, p.norm_mix + 2048, mod + 12288 + 2048, mod + 12288, (u16*)(ws + O_H), nullptr, bid, nb); break;
    case 13: phase_fox_in(p, bid, nb, smem); break;
    case 14: phase_cumsum(p, bid, nb, smem); break;
    case 15: phase_attn_fox(p, bid, nb, smem); break;
    case 16: phase_resid(p, (const u16*)(ws + O_MIX), 2048, (const u16*)(ws + O_WFOUT), X1, mod + 12288 + 4096, X1, bid, nb, smem); break;
    case 17: phase_norm(X1, p.norm_ffn + 2048, mod + 12288 + 4 * 2048, mod + 12288 + 3 * 2048, (u16*)(ws + O_H), nullptr, bid, nb); break;
    case 18: phase_ffn_up(p, (const u16*)(ws + O_W13_1), bid, nb, smem); break;
    case 19: phase_resid(p, (const u16*)(ws + O_U), F_, (const u16*)(ws + O_W2_1), X1, mod + 12288 + 5 * 2048, X1, bid, nb, smem); break;
    default: phase_norm(X1, p.final_norm, nullptr, nullptr, nullptr, p.out, bid, nb); break;
  }
}


#define XB_TMO      128
#define XB_XCNT(j)  (256  + 64 * (j))
#define XB_XSUB(j)  (1280 + 64 * (j))
#define XB_XGEN(j)  (2304 + 64 * (j))
#define XB_TOP      3328
#define XB_TOPGEN   3392
#define XCD_BAR_WORDS 3456
#define XB_SPIN_CAP (1u << 18)
#define LAS __attribute__((address_space(3)))
DI unsigned xb_ld(unsigned* p)              { return __hip_atomic_load(p, __ATOMIC_RELAXED, __HIP_MEMORY_SCOPE_AGENT); }
DI unsigned xb_add(unsigned* p, unsigned v) { return __hip_atomic_fetch_add(p, v, __ATOMIC_RELAXED, __HIP_MEMORY_SCOPE_AGENT); }
DI unsigned xb_xcc_id() { return (unsigned)__builtin_amdgcn_s_getreg((3 << 11) | 20) & 0xFu; }
#define XB_SPIN(cond, bar) do { while (cond) { __builtin_amdgcn_s_sleep(1); } } while (0)
struct XcdBarrier { unsigned* bar; unsigned x; volatile LAS unsigned* st; };
DI XcdBarrier xcd_barrier_post(unsigned* bar, volatile LAS unsigned* st) {
  XcdBarrier b; b.bar = bar; b.x = xb_xcc_id(); b.st = st;
  if (threadIdx.x == 0) st[2] = xb_add(&bar[XB_XCNT(b.x)], 1u);
  return b;
}
DI void xcd_barrier_complete(unsigned* bar, unsigned x, unsigned& nloc, unsigned& nx) {
  const unsigned G = gridDim.x * gridDim.y * gridDim.z;
  unsigned sum, cnt, mine;
  for (;;) {
    sum = 0u; cnt = 0u; mine = 0u;
#pragma unroll
    for (unsigned j = 0; j < 16; ++j) { const unsigned c = xb_ld(&bar[XB_XCNT(j)]); sum += c; cnt += (c > 0u) ? 1u : 0u; mine = (j == x) ? c : mine; }
    if (sum == G) break;
    __builtin_amdgcn_s_sleep(1);
  }
  nloc = mine > 0u ? mine : 1u; nx = cnt > 0u ? cnt : 1u;
}
DI void xcd_barrier(const XcdBarrier& b) {
  asm volatile("s_waitcnt vmcnt(0)" ::: "memory");
  __syncthreads();
  if (threadIdx.x == 0) {
    unsigned* bar = b.bar;
    __builtin_amdgcn_s_waitcnt(0);
    unsigned nloc = b.st[0], nx = b.st[1];
    if (nloc == 0u) { xcd_barrier_complete(bar, b.x, nloc, nx); b.st[0] = nloc; b.st[1] = nx; }
    const unsigned old = xb_add(&bar[XB_XSUB(b.x)], 1u);
    const unsigned gen = old / nloc;
    if (old + 1u == (gen + 1u) * nloc) {
      __builtin_amdgcn_fence(__ATOMIC_RELEASE, "agent");
      asm volatile("s_waitcnt vmcnt(0)" ::: "memory");
      const unsigned og = xb_add(&bar[XB_TOP], 1u);
      const unsigned tg = og / nx;
      if (og + 1u == (tg + 1u) * nx) xb_add(&bar[XB_TOPGEN], 1u);
      else XB_SPIN(xb_ld(&bar[XB_TOPGEN]) == tg, bar);
      __builtin_amdgcn_fence(__ATOMIC_ACQUIRE, "agent");
      xb_add(&bar[XB_XGEN(b.x)], 1u);
      asm volatile("s_waitcnt vmcnt(0)" ::: "memory");
    } else {
      XB_SPIN(xb_ld(&bar[XB_XGEN(b.x)]) == gen, bar);
      __builtin_amdgcn_fence(__ATOMIC_ACQUIRE, "agent");
      asm volatile("s_waitcnt vmcnt(0)" ::: "memory");
    }
  }
  __syncthreads();
}

#if MULTI
template <int PH> __global__ void __launch_bounds__(256, 2) phase_kernel(Params p) {
  __shared__ __attribute__((aligned(16))) char smem[SMEM_BYTES];
  run_phase(p, PH, blockIdx.x, gridDim.x, smem);
}
template <int PH> void launch_all(const Params& p, hipStream_t stream) {
  hipLaunchKernelGGL(phase_kernel<PH>, dim3(512), dim3(256), 0, stream, p);
  if constexpr (PH < NPHASE + 1) launch_all<PH + 1>(p, stream);
}
#else
__global__ void __launch_bounds__(256, 2) fwd_megakernel(Params p) {
  __shared__ __attribute__((aligned(16))) char smem[SMEM_BYTES];
  cg::grid_group grid = cg::this_grid();
  const int bid = blockIdx.x, nb = gridDim.x;
  __shared__ uint4 xb_words;
  unsigned* bar = (unsigned*)(WS(p) + O_BAR);
  if (threadIdx.x == 0) xb_words = make_uint4(0u, 0u, 0u, 0u);
  __syncthreads();
  XcdBarrier xb = xcd_barrier_post(bar, (volatile LAS unsigned*)&xb_words);
  if (nb == 12345) grid.sync();
  run_phase(p, c_prog[0], bid, nb, smem);
  xcd_barrier(xb);
  int vbid = bid;
  {
    bool even = true;
    for (int j = 0; j < 8; ++j) even = even && (xb_ld(&bar[XB_XCNT(j)]) == (unsigned)(nb >> 3));
    const int rank = (int)((volatile LAS unsigned*)&xb_words)[2];
    if (even && (nb & 7) == 0) vbid = rank * 8 + (int)xb.x;
  }
  vbid = __builtin_amdgcn_readfirstlane(vbid);
  for (int i = 1; i < NPROG; ++i) {
    const int ph = c_prog[i];
    run_phase(p, ph, vbid, nb, smem);
#ifdef PROBE_DUP
    if (ph == PROBE_DUP) { xcd_barrier(xb); run_phase(p, ph, vbid, nb, smem); }
#endif
    if (i + 1 < NPROG) xcd_barrier(xb);
  }
}
#endif

extern "C" void kernel_launch(void* const* d_in, const int* in_sizes, int n_in, void* d_out, int out_size, void* d_ws, size_t ws_size, hipStream_t stream) {
  Params p{};
  p.x = (const float*)d_in[0]; p.c = (const float*)d_in[1]; p.pos = (const int*)d_in[2];
  p.rel_bias = (const float*)d_in[3]; p.ada_w = (const float*)d_in[4]; p.ada_b = (const float*)d_in[5];
  p.norm_mix = (const float*)d_in[6]; p.norm_ffn = (const float*)d_in[7];
  p.ffn_w1 = (const float*)d_in[8]; p.ffn_w3 = (const float*)d_in[9]; p.ffn_w2 = (const float*)d_in[10];
  p.even_w_in = (const float*)d_in[11]; p.even_w_out = (const float*)d_in[12]; p.gate_b = (const float*)d_in[13];
  p.cmp_pos_k = (const float*)d_in[14]; p.cmp_w1_k = (const float*)d_in[15]; p.cmp_w2_k = (const float*)d_in[16];
  p.cmp_pos_v = (const float*)d_in[17]; p.cmp_w1_v = (const float*)d_in[18]; p.cmp_w2_v = (const float*)d_in[19];
  p.mla_q_norm = (const float*)d_in[20]; p.mla_w_uq = (const float*)d_in[21]; p.mla_kv_norm = (const float*)d_in[22]; p.mla_w_ukv = (const float*)d_in[23];
  p.fox_w_in = (const float*)d_in[24]; p.fox_w_out = (const float*)d_in[25]; p.fox_f_b = (const float*)d_in[26];
  p.fox_q_norm = (const float*)d_in[27]; p.fox_k_norm = (const float*)d_in[28]; p.final_norm = (const float*)d_in[29];
  p.out = (float*)d_out; p.ws = (char*)d_ws;
  for (int j = 0; j < NJOBS; ++j) p.jobs[j] = get_job(p, j);
  for (int j = 0; j < 32; ++j) p.inv_freq[j] = (float)pow(10000.0, -(double)j / 32.0);
  for (int b = 0; b < 32; ++b) p.t5thr[b] = b < 16 ? b : (int)ceil(16.0 * pow(2.0, (b - 16) * 0.5));
  if (ws_size < WS_NEED) { fprintf(stderr, "workspace too small: %zu < %zu\n", ws_size, (size_t)WS_NEED); return; }
#if MULTI
  launch_all<0>(p, stream);
#else
  static int grid_blocks = 0;
  if (!grid_blocks) {
    int dev = 0, cus = 0, per_cu = 0;
    (void)hipGetDevice(&dev);
    (void)hipDeviceGetAttribute(&cus, hipDeviceAttributeMultiprocessorCount, dev);
    (void)hipOccupancyMaxActiveBlocksPerMultiprocessor(&per_cu, fwd_megakernel, 256, 0);
    if (per_cu > 2) per_cu = 2;
    grid_blocks = cus * per_cu;
  }
  (void)hipMemsetAsync((char*)d_ws + O_BAR, 0, XCD_BAR_WORDS * sizeof(unsigned), stream);
  void* args[] = {&p};
  hipError_t e = hipLaunchCooperativeKernel((void*)fwd_megakernel, dim3(grid_blocks), dim3(256), args, 0, stream);
  if (e != hipSuccess) fprintf(stderr, "cooperative launch failed: %s (grid %d)\n", hipGetErrorString(e), grid_blocks);
#endif
}
```
